# Optimizing an MI355X kernel written in HIP

```python
import jax, jax.numpy as jnp
from jax import lax
import numpy as np

D_MODEL = 2048
BATCH = 4
SEQ = 2048
DEPTH = 4
DEC_BATCH = 128
DEC_SEQ = 8
PAST_LEN = 16384
PAGE_SIZE = 128

D_A = D_MODEL // 2
HEAD_A = 64
N_HEADS_A = D_A // HEAD_A
LORA_W = 64
LORA_A = 64
D_B = D_MODEL // 4
POOL_WINDOWS = (2, 4, 8, 16)
N_POOL = len(POOL_WINDOWS)
POOL_GC = D_B // N_POOL
POOL_BUF = max(POOL_WINDOWS) - 1
D_C = D_MODEL - D_A - D_B
N_GROUPS_C = 4
GC = D_C // N_GROUPS_C
CHUNK = 128
SHIFT_W = 3 * D_A + LORA_W + LORA_A
SPLIT_SIZES = (SHIFT_W, D_A, D_B, D_B, D_C, D_C, D_C)
SPLIT_IDX = tuple(int(i) for i in np.cumsum(SPLIT_SIZES)[:-1])
D_IN = sum(SPLIT_SIZES)
EPS = 1e-6
GN_EPS = HEAD_A * 1e-5
LN_EPS = 1e-5

kernel_name = "hybrid_rwkv7_pool_chunkgate_decode_step"

F32 = jnp.float32


def rms_norm(x, g):
    xf = x.astype(F32)
    y = xf * lax.rsqrt(jnp.mean(xf * xf, axis=-1, keepdims=True) + EPS)
    return (y * g.astype(F32)).astype(x.dtype)


def wkv7_scan(r, w, k, v, kk, a, s0):
    def step(S, inp):
        r_t, w_t, k_t, v_t, kk_t, a_t = inp
        sa = jnp.einsum('bhij,bhj->bhi', S, -kk_t)
        S = (S * w_t[:, :, None, :] + sa[..., None] * (kk_t * a_t)[:, :, None, :]
             + v_t[..., None] * k_t[:, :, None, :])
        return S, jnp.einsum('bhij,bhj->bhi', S, r_t)
    xs = tuple(jnp.moveaxis(t, 1, 0) for t in (r, w, k, v, kk, a))
    s_T, ys = lax.scan(step, s0, xs)
    return jnp.moveaxis(ys, 0, 1), s_T


def rwkv7_mix(ps, prev, s0, mu, w0, w_up, a0, a_up, k_k, k_a, r_k, lnx_g, lnx_b):
    B, T, _ = ps.shape
    psf = ps.astype(F32)
    shifted = jnp.concatenate([prev.astype(F32)[:, None], psf[:, :-1]], axis=1)
    xs = psf + (shifted - psf) * mu.astype(F32)
    r, k, v, xw, xa = jnp.split(xs, [D_A, 2 * D_A, 3 * D_A, 3 * D_A + LORA_W], axis=-1)
    w_log = -jax.nn.softplus(-(w0 + jnp.tanh(xw) @ w_up)) - 0.5
    w = jnp.exp(-jnp.exp(w_log))
    a = jax.nn.sigmoid(a0 + xa @ a_up)
    hs = lambda t: t.reshape(B, T, N_HEADS_A, HEAD_A)
    kk = hs(k * k_k)
    kk = kk * lax.rsqrt(jnp.maximum(jnp.sum(kk * kk, axis=-1, keepdims=True), 1e-12))
    k = k * (1.0 + (a - 1.0) * k_a)
    r, w, k, v, a = hs(r), hs(w), hs(k), hs(v), hs(a)
    y, s_T = wkv7_scan(r, w, k, v, kk, a, s0.astype(F32))
    ym = jnp.mean(y, axis=-1, keepdims=True)
    yv = jnp.mean(jnp.square(y - ym), axis=-1, keepdims=True)
    yn = ((y - ym) * lax.rsqrt(yv + GN_EPS)).reshape(B, T, D_A) * lnx_g + lnx_b
    bonus = (jnp.sum(r * k * r_k, axis=-1, keepdims=True) * v).reshape(B, T, D_A)
    return yn + bonus, ps[:, -1], s_T


def pool_mix(u, buf, pos0, pool_w, pool_scale):
    B, T, _ = u.shape
    full = jnp.concatenate([buf.astype(F32), u.astype(F32)], axis=1)
    cs = jnp.concatenate([jnp.zeros((B, 1, D_B), F32), jnp.cumsum(full, axis=1)], axis=1)
    hi = cs[:, POOL_BUF + 1:]
    pos = pos0 + jnp.arange(T)
    groups = []
    for g, win in enumerate(POOL_WINDOWS):
        sl = slice(g * POOL_GC, (g + 1) * POOL_GC)
        lo = cs[:, POOL_BUF + 1 - win:POOL_BUF + 1 - win + T, sl]
        cnt = jnp.minimum(pos + 1, win).astype(F32)[None, :, None]
        groups.append((hi[..., sl] - lo) / cnt)
    pooled = jnp.concatenate(groups, axis=-1) - full[:, POOL_BUF:]
    mixed = jnp.einsum('btgc,gcd->btgd', pooled.reshape(B, T, N_POOL, POOL_GC), pool_w)
    mixed = mixed.reshape(B, T, D_B) * pool_scale
    return mixed, full[:, -POOL_BUF:].astype(u.dtype)


def chunk_gate(u, v, ln_g, w_s, b_s):
    B, T, _ = v.shape
    vf = v.astype(F32)
    vm = jnp.mean(vf, axis=-1, keepdims=True)
    vv = jnp.mean(jnp.square(vf - vm), axis=-1, keepdims=True)
    vn = (vf - vm) * lax.rsqrt(vv + LN_EPS) * ln_g
    L = min(T, CHUNK)
    n = -(-T // L)
    pad = n * L - T
    ws = w_s[:, :L, :L] * jnp.tril(jnp.ones((L, L), F32))
    vp = jnp.pad(vn, ((0, 0), (0, pad), (0, 0))).reshape(B, n, L, N_GROUPS_C, GC)
    mix = jnp.einsum('gts,bnsgc->bntgc', ws, vp) + jnp.transpose(b_s[:, :L])[None, None, :, :, None]
    mix = mix.reshape(B, n * L, D_C)[:, :T]
    return u.astype(F32) * mix, vn.astype(v.dtype)


def hybrid_layer(x, st_shift, st_wkv, st_pool, pos0, p):
    h = rms_norm(x, p['norm_g'])
    proj = h @ p['w_in']
    ps, g_a, u_b, g_b, u_c, v_c, g_c = jnp.split(proj, SPLIT_IDX, axis=-1)
    y_a, new_shift, new_wkv = rwkv7_mix(ps, st_shift, st_wkv, p['mu'], p['w0'], p['w_up'], p['a0'],
                                        p['a_up'], p['k_k'], p['k_a'], p['r_k'], p['lnx_g'], p['lnx_b'])
    y_b, new_pool = pool_mix(u_b, st_pool, pos0, p['pool_w'], p['pool_scale'])
    y_c, vn_c = chunk_gate(u_c, v_c, p['gmlp_ln_g'], p['gmlp_ws'], p['gmlp_b'])
    cat = jnp.concatenate([y_a * jax.nn.silu(g_a.astype(F32)),
                           y_b * jax.nn.silu(g_b.astype(F32)),
                           y_c * jax.nn.silu(g_c.astype(F32))], axis=-1)
    out = x + (cat @ p['w_out'].astype(F32)).astype(x.dtype)
    return out, new_shift, new_wkv, new_pool, vn_c


def setup_inputs(seed: int = 0) -> dict:
    key = jax.random.key(seed)
    ks = jax.random.split(key, 26)
    nrm = lambda k, s: jax.random.normal(k, s, F32)
    return {
        "x_prompt": nrm(ks[0], (BATCH, SEQ, D_MODEL)),
        "x_sample": nrm(ks[1], (DEC_BATCH, DEC_SEQ, D_MODEL)),
        "state_shift": nrm(ks[2], (DEPTH, DEC_BATCH, SHIFT_W)),
        "state_wkv": 0.3 * nrm(ks[3], (DEPTH, DEC_BATCH, N_HEADS_A, HEAD_A, HEAD_A)),
        "state_pool": nrm(ks[4], (DEPTH, DEC_BATCH, POOL_BUF, D_B)),
        "norm_g": 1.0 + 0.02 * nrm(ks[5], (DEPTH, D_MODEL)),
        "final_norm_g": 1.0 + 0.02 * nrm(ks[6], (D_MODEL,)),
        "w_in": nrm(ks[7], (DEPTH, D_MODEL, D_IN)) * D_MODEL ** -0.5,
        "shift_mu": jax.random.uniform(ks[8], (DEPTH, SHIFT_W), F32),
        "w0": -0.5 + 0.5 * nrm(ks[9], (DEPTH, D_A)),
        "w_up": 0.1 * nrm(ks[10], (DEPTH, LORA_W, D_A)) * LORA_W ** -0.5,
        "a0": 0.1 * nrm(ks[11], (DEPTH, D_A)),
        "a_up": 0.1 * nrm(ks[12], (DEPTH, LORA_A, D_A)) * LORA_A ** -0.5,
        "k_k": 0.85 + 0.05 * nrm(ks[13], (DEPTH, D_A)),
        "k_a": 1.0 + 0.05 * nrm(ks[14], (DEPTH, D_A)),
        "r_k": 0.1 * nrm(ks[15], (DEPTH, N_HEADS_A, HEAD_A)),
        "lnx_g": 1.0 + 0.02 * nrm(ks[16], (DEPTH, D_A)),
        "lnx_b": 0.02 * nrm(ks[17], (DEPTH, D_A)),
        "pool_w": nrm(ks[18], (DEPTH, N_POOL, POOL_GC, POOL_GC)) * POOL_GC ** -0.5,
        "pool_scale": 0.5 + 0.1 * nrm(ks[19], (DEPTH, D_B)),
        "gmlp_ln_g": 1.0 + 0.02 * nrm(ks[20], (DEPTH, D_C)),
        "gmlp_ws": nrm(ks[21], (DEPTH, N_GROUPS_C, CHUNK, CHUNK)) * CHUNK ** -0.5,
        "gmlp_b": 1.0 + 0.1 * nrm(ks[22], (DEPTH, N_GROUPS_C, CHUNK)),
        "w_out": 0.5 * nrm(ks[23], (DEPTH, D_MODEL, D_MODEL)) * D_MODEL ** -0.5,
    }


def reference(x_prompt, x_sample, state_shift, state_wkv, state_pool, norm_g, final_norm_g, w_in,
              shift_mu, w0, w_up, a0, a_up, k_k, k_a, r_k, lnx_g, lnx_b, pool_w, pool_scale,
              gmlp_ln_g, gmlp_ws, gmlp_b, w_out):
    bp = x_prompt.shape[0]
    xp, xs = x_prompt, x_sample
    p_shift, p_wkv, p_pool = [], [], []
    s_shift, s_wkv, s_pool, s_v = [], [], [], []
    for l in range(DEPTH):
        prm = dict(norm_g=norm_g[l], w_in=w_in[l], mu=shift_mu[l], w0=w0[l], w_up=w_up[l], a0=a0[l],
                   a_up=a_up[l], k_k=k_k[l], k_a=k_a[l], r_k=r_k[l], lnx_g=lnx_g[l], lnx_b=lnx_b[l],
                   pool_w=pool_w[l], pool_scale=pool_scale[l], gmlp_ln_g=gmlp_ln_g[l],
                   gmlp_ws=gmlp_ws[l], gmlp_b=gmlp_b[l], w_out=w_out[l])
        xp, sh, wk, po, _ = hybrid_layer(
            xp, jnp.zeros((bp, SHIFT_W), xp.dtype), jnp.zeros((bp, N_HEADS_A, HEAD_A, HEAD_A), F32),
            jnp.zeros((bp, POOL_BUF, D_B), xp.dtype), 0, prm)
        p_shift.append(sh); p_wkv.append(wk); p_pool.append(po)
        xs, sh, wk, po, vc = hybrid_layer(xs, state_shift[l], state_wkv[l], state_pool[l], PAST_LEN, prm)
        s_shift.append(sh); s_wkv.append(wk); s_pool.append(po); s_v.append(vc)
    y_prompt = rms_norm(xp, final_norm_g)
    y_sample = rms_norm(xs, final_norm_g)
    return (y_prompt, y_sample, jnp.stack(p_shift), jnp.stack(p_wkv), jnp.stack(p_pool),
            jnp.stack(s_shift), jnp.stack(s_wkv), jnp.stack(s_pool), jnp.stack(s_v))
```

```cpp
#include <hip/hip_runtime.h>
#include <hip/hip_cooperative_groups.h>
#include <cstdio>
namespace cg = cooperative_groups;
namespace pg8 {
#define PG8_LAS __attribute__((address_space(3)))
typedef unsigned short bf16_t;
typedef short bf16x8 __attribute__((ext_vector_type(8)));
typedef float f32x4 __attribute__((ext_vector_type(4)));
typedef unsigned u32x4 __attribute__((ext_vector_type(4)));
constexpr int BM = 256, BK = 64, HALF = 128, HTB = HALF * BK * 2  , STAGE_BYTES = 8 * HTB, NXCD = 8, WGM = 8;

__host__ __device__ __forceinline__ int lds_byte(int r, int c) { const int st = (r >> 4) * 2 + (c >> 5), rr = r & 15, cc = c & 31, ob = rr * 64 + cc * 2; return st * 1024 + (ob ^ (((ob >> 9) & 1) << 5)); }
__host__ __device__ __forceinline__ void stage_rc(int b, int& R, int& C) { const int st = b / 1024, sb = b % 1024, swz = sb ^ (((sb >> 9) & 1) << 5); R = (st >> 1) * 16 + swz / 64; C = (st & 1) * 32 + (swz % 64) / 2; }
__host__ __device__ __forceinline__ int perm32(int rho) { const int n = rho >> 4, i = rho & 15; return 8 * (i >> 2) + 4 * n + (i & 3); }

struct Unit { int pm, pn; };
struct Gemm { const bf16_t* A; const bf16_t* Bt; int M, N, K; };

struct StaticOrder {
    int nM, nN, nwg, G, c;
    __host__ __device__ void init(int M, int N, int G_, int c_) { nM = M / BM; nN = N / BM; nwg = nM * nN; G = G_; c = c_; }
    __host__ __device__ bool next(int i, Unit& u) const {
        const long L = (long)i * G + c; if (L >= nwg) return false;
        int wgid = (int)L; { const int q = nwg / NXCD, r = nwg % NXCD, xcd = wgid % NXCD, off = wgid / NXCD; wgid = (xcd < r ? xcd * (q + 1) : r * (q + 1) + (xcd - r) * q) + off; }
        const int nig = WGM * nN, gid = wgid / nig, fm = gid * WGM, gsz = (nM - fm) < WGM ? (nM - fm) : WGM;
        u.pm = fm + ((wgid % nig) % gsz); u.pn = (wgid % nig) / gsz; return true;
    }
    __device__ __forceinline__ void a_ready(const Unit&) const {}
    __device__ __forceinline__ void done(const Unit&) const {}
};

template <class Epi, class Sched, bool STAMP = false>
__device__ __forceinline__ void gemm_phase(PG8_LAS unsigned char* lds, const Gemm g, const Sched& S, const Epi& E, unsigned long long* stamps, int zz) {
    const int tid = threadIdx.x + zz, wid = __builtin_amdgcn_readfirstlane(tid >> 6), lane = tid & 63, wr = wid >> 2, wc = wid & 3, fr = lane & 15, fq = lane >> 4;
    const int K = g.K, nt = K / BK;
    int ts_lo = 0, ts_hi = 0, nts = 0; const unsigned long long rt_entry = STAMP ? (unsigned long long)wall_clock64() : 0ull;
#define PG8_STAMP() do { if (STAMP && wid == 0 && nts < 64) { const unsigned long long _c = (unsigned long long)clock64(); \
        ts_lo = (lane == nts) ? (int)(unsigned)_c : ts_lo; ts_hi = (lane == nts) ? (int)(unsigned)(_c >> 32) : ts_hi; ++nts; } } while (0)
    PG8_STAMP();
    unsigned voffA[2], voffB[2];
#pragma unroll
    for (int i = 0; i < 2; ++i) { int R, C; stage_rc(tid * 16 + i * 8192, R, C); const int Rb = Epi::PERM ? ((R & ~31) + perm32(R & 31)) : R;
        voffA[i] = (unsigned)(R * K + C) * 2u; voffB[i] = (unsigned)(Rb * K + C) * 2u; }
    const size_t kstep = (size_t)(BK * 2);
    const size_t hstep = (size_t)HALF * K * 2;
    const size_t tstep = 2 * hstep;
    const unsigned ldsw = (unsigned)wid * 1024u;
    const int aoff = lds_byte(wr * 64 + fr, fq * 8), boff = lds_byte(wc * 32 + fr, fq * 8);
#define PG8_SA(b, h) (((b) * 2 + (h)) * HTB)
#define PG8_SB(b, h) ((4 + (b) * 2 + (h)) * HTB)
#define PG8_STAGE(bufoff, gbase, voff) do { _Pragma("unroll") for (int _i = 0; _i < 2; ++_i) \
        __builtin_amdgcn_global_load_lds((const unsigned*)((const char*)(gbase) + (voff)[_i]), (PG8_LAS unsigned*)(lds + (bufoff) + ldsw + _i * 8192), 16, 0, 0); } while (0)
#define PG8_LDA(dst, b, h) do { _Pragma("unroll") for (int m = 0; m < 4; ++m) _Pragma("unroll") for (int k = 0; k < 2; ++k) dst[m][k] = *(const PG8_LAS bf16x8*)(lds + PG8_SA(b, h) + aoff + m * 2048 + k * 1024); } while (0)
#define PG8_LDB(dst, b, h) do { _Pragma("unroll") for (int n = 0; n < 2; ++n) _Pragma("unroll") for (int k = 0; k < 2; ++k) dst[n][k] = *(const PG8_LAS bf16x8*)(lds + PG8_SB(b, h) + boff + n * 2048 + k * 1024); } while (0)
#define PG8_MMA(ai, bj, At, Bt) do { __builtin_amdgcn_s_setprio(1); _Pragma("unroll") for (int m = 0; m < 4; ++m) _Pragma("unroll") for (int n = 0; n < 2; ++n) _Pragma("unroll") for (int k = 0; k < 2; ++k) \
        acc[ai][bj][m][n] = __builtin_amdgcn_mfma_f32_16x16x32_bf16(Bt[n][k], At[m][k], acc[ai][bj][m][n], 0, 0, 0); __builtin_amdgcn_s_setprio(0); } while (0)
#define PG8_WAIT_V(n) asm volatile("s_waitcnt vmcnt(" #n ")" ::: "memory")
#define PG8_WAIT_L(n) asm volatile("s_waitcnt lgkmcnt(" #n ")" ::: "memory")
#define PG8_BAR __builtin_amdgcn_s_barrier()
#define PG8_SCHED __builtin_amdgcn_sched_barrier(0)
    Unit cur, nxt; int ui = 0;
    if (!S.next(0, cur)) return;
    f32x4 acc[2][2][4][2];
#pragma unroll
    for (int a = 0; a < 2; ++a)
#pragma unroll
        for (int b = 0; b < 2; ++b)
#pragma unroll
            for (int m = 0; m < 4; ++m)
#pragma unroll
                for (int n = 0; n < 2; ++n) acc[a][b][m][n] = (f32x4){0.f, 0.f, 0.f, 0.f};
    bf16x8 At[4][2], B0[2][2], B1[2][2];
    const char* cA = (const char*)g.A + (size_t)cur.pm * tstep; const char* cB = (const char*)g.Bt + (size_t)cur.pn * tstep;
    S.a_ready(cur);
    PG8_STAGE(PG8_SB(0, 0), cB, voffB); PG8_STAGE(PG8_SA(0, 0), cA, voffA); PG8_STAGE(PG8_SB(0, 1), cB + hstep, voffB); PG8_STAGE(PG8_SA(0, 1), cA + hstep, voffA);
    if (wr == 1) PG8_BAR;
    PG8_WAIT_V(4); PG8_BAR;
    PG8_STAGE(PG8_SB(1, 0), cB + kstep, voffB); PG8_STAGE(PG8_SA(1, 0), cA + kstep, voffA); PG8_STAGE(PG8_SB(1, 1), cB + hstep + kstep, voffB);
    PG8_WAIT_V(6); PG8_BAR;
    PG8_STAMP();
    for (;;) {
        const bool has_next = S.next(ui + 1, nxt);
        const char* nA = has_next ? (const char*)g.A + (size_t)nxt.pm * tstep : cA; const char* nB = has_next ? (const char*)g.Bt + (size_t)nxt.pn * tstep : cB;
        for (int t = 0; t < nt; t += 2) {
            const bool last = (t == nt - 2);
            const char* a1 = cA + (size_t)(t + 1) * kstep;
            const char* a2 = last ? nA : cA + (size_t)(t + 2) * kstep; const char* b2 = last ? nB : cB + (size_t)(t + 2) * kstep;
            const char* a3 = a2 + kstep; const char* b3 = b2 + kstep;
            if (last && has_next) S.a_ready(nxt);
            PG8_LDB(B0, 0, 0); PG8_SCHED; PG8_LDA(At, 0, 0); PG8_STAGE(PG8_SA(1, 1), a1 + hstep, voffA);
            PG8_WAIT_L(8); PG8_BAR; PG8_WAIT_L(0); PG8_MMA(0, 0, At, B0); PG8_BAR; PG8_SCHED;
            PG8_LDB(B1, 0, 1); PG8_STAGE(PG8_SB(0, 0), b2, voffB);
            PG8_BAR; PG8_WAIT_L(0); PG8_MMA(0, 1, At, B1); PG8_BAR;
            PG8_LDA(At, 0, 1); PG8_STAGE(PG8_SA(0, 0), a2, voffA);
            PG8_BAR; PG8_WAIT_L(0); PG8_MMA(1, 0, At, B0); PG8_BAR; PG8_SCHED;
            PG8_STAGE(PG8_SB(0, 1), b2 + hstep, voffB);
            PG8_WAIT_V(6); PG8_BAR; PG8_MMA(1, 1, At, B1); PG8_BAR;
            PG8_LDB(B0, 1, 0); PG8_SCHED; PG8_LDA(At, 1, 0); PG8_STAGE(PG8_SA(0, 1), a2 + hstep, voffA);
            PG8_WAIT_L(8); PG8_BAR; PG8_WAIT_L(0); PG8_MMA(0, 0, At, B0); PG8_BAR; PG8_SCHED;
            PG8_LDB(B1, 1, 1); PG8_STAGE(PG8_SB(1, 0), b3, voffB);
            PG8_BAR; PG8_WAIT_L(0); PG8_MMA(0, 1, At, B1); PG8_BAR;
            PG8_LDA(At, 1, 1); PG8_STAGE(PG8_SA(1, 0), a3, voffA);
            PG8_BAR; PG8_WAIT_L(0); PG8_MMA(1, 0, At, B0); PG8_BAR; PG8_SCHED;
            PG8_STAGE(PG8_SB(1, 1), b3 + hstep, voffB);
            PG8_WAIT_V(6); PG8_BAR; PG8_MMA(1, 1, At, B1); PG8_BAR;
        }
        PG8_STAMP();
        if constexpr (!Epi::AFTER_DRAIN) { E(acc, cur, wr, wc, fr, fq); S.done(cur); }
        PG8_STAMP();
        if (!has_next) break;
#pragma unroll
        for (int a = 0; a < 2; ++a)
#pragma unroll
            for (int b = 0; b < 2; ++b)
#pragma unroll
                for (int m = 0; m < 4; ++m)
#pragma unroll
                    for (int n = 0; n < 2; ++n) acc[a][b][m][n] = (f32x4){0.f, 0.f, 0.f, 0.f};
        cur = nxt; cA = nA; cB = nB; ++ui;
    }
    PG8_WAIT_V(0);
    if (wr == 0) PG8_BAR;
    PG8_BAR;
    if constexpr (Epi::AFTER_DRAIN) { E.fused(acc, cur, wr, wc, fr, fq, lds, wid, lane); S.done(cur); }
    PG8_STAMP();
    if (STAMP && wid == 0) { stamps[lane] = lane < nts ? (((unsigned long long)(unsigned)ts_hi << 32) | (unsigned)ts_lo) : 0ull;
        if (lane == 62) stamps[62] = rt_entry; if (lane == 63) stamps[63] = (unsigned long long)wall_clock64(); }
#undef PG8_STAMP
#undef PG8_SA
#undef PG8_SB
#undef PG8_STAGE
#undef PG8_LDA
#undef PG8_LDB
#undef PG8_MMA
#undef PG8_WAIT_V
#undef PG8_WAIT_L
#undef PG8_BAR
#undef PG8_SCHED
}
}
using pg8::bf16_t; using pg8::bf16x8; using pg8::f32x4; using pg8::u32x4;
typedef unsigned u32x2 __attribute__((ext_vector_type(2)));
#define DEVINL __device__ __forceinline__
#define PIN(i) (p.in[(i) + z])
#define PWS ws_
#define POUT out_
#define LAUNDER_PTRS unsigned char* ws_ = p.ws; float* out_ = p.out; asm volatile("" : "+s"(ws_), "+s"(out_))

constexpr int DM = 2048, MTOT = 9216, MP = 8192, DIN = 6784, DINP = 6912, NL = 4, SHW = 3200;
constexpr int C_GA = 3200, C_UB = 4224, C_GB = 4736, C_UC = 5248, C_VC = 5760, C_GC = 6272;
constexpr size_t O_YP = 0, O_PSHIFT = 18874368, O_PWKV = 18925568, O_PPOOL = 19974144, O_SSHIFT = 20097024, O_SWKV = 21735424, O_SPOOL = 55289856, O_SV = 59222016, O_END = 61319168;
constexpr size_t SCAN_STRIDE = (size_t)MTOT * 1024;
constexpr size_t WS_WINT = 0;
constexpr size_t WS_WOUTT = WS_WINT + (size_t)NL * DINP * DM * 2;
constexpr size_t WS_XB = WS_WOUTT + (size_t)NL * DM * DM * 2;
constexpr size_t WS_XF = WS_XB + (size_t)MTOT * DM * 2;
constexpr size_t WS_PROJ = WS_XF + (size_t)MTOT * DM * 4;
constexpr size_t WS_CAT = WS_PROJ + (size_t)MTOT * DINP * 2;
constexpr size_t WS_SCAN = WS_CAT + (size_t)MTOT * DM * 2;
constexpr size_t WS_Y = WS_SCAN + 6 * SCAN_STRIDE * 4;
constexpr size_t WS_RKB = WS_Y + SCAN_STRIDE * 4;
constexpr size_t WS_SSQ = WS_RKB + (size_t)MTOT * 16 * 4;
constexpr size_t WS_WUPT = WS_SSQ + (size_t)5 * MTOT * 4;
constexpr size_t WS_AUPT = WS_WUPT + (size_t)NL * 1024 * 64 * 2;
constexpr size_t WS_POOLWT = WS_AUPT + (size_t)NL * 1024 * 64 * 2;
constexpr size_t WS_END = WS_POOLWT + (size_t)NL * 4 * 128 * 128 * 2;
constexpr int LDS_BYTES = 131072;

struct Params { const float* in[24]; float* out; unsigned char* ws; };
enum { I_XP = 0, I_XS, I_SSHIFT, I_SWKV, I_SPOOL, I_NORMG, I_FNORMG, I_WIN, I_MU, I_W0, I_WUP, I_A0, I_AUP, I_KK, I_KA, I_RK, I_LNXG, I_LNXB, I_POOLW, I_POOLS, I_GLNG, I_GWS, I_GB, I_WOUT };

DEVINL unsigned cvt_pk(float lo, float hi) { unsigned r; asm volatile("v_cvt_pk_bf16_f32 %0, %1, %2" : "=v"(r) : "v"(lo), "v"(hi)); return r; }
DEVINL bf16_t f2bf(float f) { unsigned u = __float_as_uint(f); u += 0x7FFFu + ((u >> 16) & 1u); return (bf16_t)(u >> 16); }
DEVINL float bf2f(bf16_t b) { return __uint_as_float(((unsigned)b) << 16); }
DEVINL f32x4 ld4bf(const bf16_t* p) { const u32x2 w = *(const u32x2*)p; f32x4 r; r[0] = __uint_as_float(w.x << 16); r[1] = __uint_as_float(w.x & 0xFFFF0000u); r[2] = __uint_as_float(w.y << 16); r[3] = __uint_as_float(w.y & 0xFFFF0000u); return r; }
DEVINL void st4bf(bf16_t* p, f32x4 v) { u32x2 w; w.x = cvt_pk(v[0], v[1]); w.y = cvt_pk(v[2], v[3]); *(u32x2*)p = w; }
DEVINL float siluf(float x) { return x / (1.f + __expf(-x)); }
template <int CTRL> DEVINL float dpp_add(float x) { return x + __int_as_float(__builtin_amdgcn_update_dpp(0, __float_as_int(x), CTRL, 0xF, 0xF, false)); }
DEVINL float allreduce16(float x) { x = dpp_add<0x128>(x); x = dpp_add<0x124>(x); x = dpp_add<0x122>(x); x = dpp_add<0x121>(x); return x; }
DEVINL float xq_sum(float x) { x += __shfl_xor(x, 16); x += __shfl_xor(x, 32); return x; }
DEVINL float wave_sum(float x) { for (int o = 32; o > 0; o >>= 1) x += __shfl_xor(x, o); return x; }
DEVINL f32x4 mfma16(bf16x8 a, bf16x8 b, f32x4 c) { return __builtin_amdgcn_mfma_f32_16x16x32_bf16(a, b, c, 0, 0, 0); }

struct EpiProj {
    static constexpr bool PERM = true, AFTER_DRAIN = false;
    bf16_t* O; const float* ssq;
    DEVINL void operator()(const f32x4 (&acc)[2][2][4][2], const pg8::Unit& u, int wr, int wc, int fr, int fq) const {
        const int row0 = u.pm * 256 + wr * 64 + fr, col0 = u.pn * 256 + wc * 32 + 8 * fq;
#pragma unroll
        for (int ai = 0; ai < 2; ++ai)
#pragma unroll
            for (int m = 0; m < 4; ++m) {
                const int row = row0 + ai * 128 + m * 16;
                const float rs = rsqrtf(ssq[row] * (1.0f / 2048.0f) + 1e-6f);
                bf16_t* rowp = O + (size_t)row * DINP + col0;
#pragma unroll
                for (int bj = 0; bj < 2; ++bj) {
                    const f32x4 v0 = acc[ai][bj][m][0] * rs, v1 = acc[ai][bj][m][1] * rs;
                    u32x4 w; w.x = cvt_pk(v0[0], v0[1]); w.y = cvt_pk(v0[2], v0[3]); w.z = cvt_pk(v1[0], v1[1]); w.w = cvt_pk(v1[2], v1[3]);
                    *(u32x4*)(rowp + bj * 128) = w;
                }
            }
    }
};
struct EpiRes {
    static constexpr bool PERM = false, AFTER_DRAIN = false;
    const float* srcP; const float* srcS; float* xf; bf16_t* xb; float* ssq_next;
    DEVINL void operator()(const f32x4 (&acc)[2][2][4][2], const pg8::Unit& u, int wr, int wc, int fr, int fq) const {
        const int row0 = u.pm * 256 + wr * 64 + fr, col0 = u.pn * 256 + wc * 32 + 4 * fq;
#pragma unroll
        for (int ai = 0; ai < 2; ++ai)
#pragma unroll
            for (int m = 0; m < 4; ++m) {
                const int row = row0 + ai * 128 + m * 16;
                const float* src = (row < MP ? srcP + (size_t)row * DM : srcS + (size_t)(row - MP) * DM) + col0;
                float* dst = xf + (size_t)row * DM + col0; bf16_t* dsb = xb + (size_t)row * DM + col0;
                float part = 0.f;
#pragma unroll
                for (int bj = 0; bj < 2; ++bj)
#pragma unroll
                    for (int n = 0; n < 2; ++n) {
                        const int co = bj * 128 + n * 16;
                        const f32x4 y = *(const f32x4*)(src + co) + acc[ai][bj][m][n];
                        *(f32x4*)(dst + co) = y; st4bf(dsb + co, y);
                        part += y[0] * y[0] + y[1] * y[1] + y[2] * y[2] + y[3] * y[3];
                    }
                part = xq_sum(part);
                if (fq == 0) atomicAdd(ssq_next + row, part);
            }
    }
};
DEVINL void phase0(const Params& p, unsigned char* lds, int z) {
    LAUNDER_PTRS;
    const int tid = (int)(threadIdx.x + z), G = gridDim.x, bid = (int)(blockIdx.x + z), lane = tid & 63;
    float* tile = (float*)lds;
    bf16_t* WinT = (bf16_t*)(PWS + WS_WINT); bf16_t* WoutT = (bf16_t*)(PWS + WS_WOUTT);
    constexpr int NT_IN = 32 * 106, NT_OUT = 32 * 32, TOTAL = NL * (NT_IN + NT_OUT);
    for (int it = bid; it < TOTAL; it += G) {
        int l, kt, nt, ld; const float* src; const float* gs; bf16_t* dst;
        if (it < NL * NT_IN) { l = it / NT_IN; const int r = it % NT_IN; nt = r % 106; kt = r / 106; ld = DIN; src = PIN(I_WIN) + (size_t)l * DM * DIN; gs = PIN(I_NORMG) + l * DM; dst = WinT + (size_t)l * DINP * DM; }
        else { const int j = it - NL * NT_IN; l = j / NT_OUT; const int r = j % NT_OUT; nt = r % 32; kt = r / 32; ld = DM; src = PIN(I_WOUT) + (size_t)l * DM * DM; gs = nullptr; dst = WoutT + (size_t)l * DM * DM; }
#pragma unroll
        for (int ps = 0; ps < 2; ++ps) {
            const int row = (tid >> 4) + ps * 32, c4 = (tid & 15) * 4;
            const float4 v = *(const float4*)(src + (size_t)(kt * 64 + row) * ld + nt * 64 + c4);
            const float s = gs ? gs[kt * 64 + row] : 1.f;
            float* tp = tile + row * 65 + c4; tp[0] = v.x * s; tp[1] = v.y * s; tp[2] = v.z * s; tp[3] = v.w * s;
        }
        __syncthreads();
        { const int n = tid >> 3, kg = (tid & 7) * 8; const float* tp = tile + kg * 65 + n;
          u32x4 w; w.x = cvt_pk(tp[0], tp[65]); w.y = cvt_pk(tp[130], tp[195]); w.z = cvt_pk(tp[260], tp[325]); w.w = cvt_pk(tp[390], tp[455]);
          *(u32x4*)(dst + (size_t)(nt * 64 + n) * DM + kt * 64 + kg) = w; }
        __syncthreads();
    }
    const int gtid = bid * 512 + tid, gthreads = G * 512;
    for (int i = gtid; i < NL * 128 * 256; i += gthreads) { const int l = i / (128 * 256), r = i % (128 * 256); *(u32x4*)(WinT + ((size_t)l * DINP + DIN) * DM + (size_t)r * 8) = (u32x4){0u, 0u, 0u, 0u}; }
    bf16_t* xb = (bf16_t*)(PWS + WS_XB); float* ssq = (float*)(PWS + WS_SSQ);
    for (int m = bid * 8 + (tid >> 6); m < MTOT; m += G * 8) {
        const float* src = m < MP ? PIN(I_XP) + (size_t)m * DM : PIN(I_XS) + (size_t)(m - MP) * DM;
        float ss = 0.f;
#pragma unroll
        for (int i = 0; i < 8; ++i) { const f32x4 v = *(const f32x4*)(src + i * 256 + lane * 4); ss += v[0] * v[0] + v[1] * v[1] + v[2] * v[2] + v[3] * v[3]; st4bf(xb + (size_t)m * DM + i * 256 + lane * 4, v); }
        ss = wave_sum(ss);
        if (lane == 0) ssq[m] = ss;
    }
    for (int i = gtid; i < 4 * MTOT; i += gthreads) ssq[MTOT + i] = 0.f;
    bf16_t* wupT = (bf16_t*)(PWS + WS_WUPT); bf16_t* aupT = (bf16_t*)(PWS + WS_AUPT); bf16_t* poolwT = (bf16_t*)(PWS + WS_POOLWT);
    for (int i = gtid; i < NL * 1024 * 64; i += gthreads) { const int l = i >> 16, c = (i >> 6) & 1023, j = i & 63; const size_t s = ((size_t)l * 64 + j) * 1024 + c; wupT[i] = f2bf(PIN(I_WUP)[s]); aupT[i] = f2bf(PIN(I_AUP)[s]); }
    for (int i = gtid; i < NL * 4 * 128 * 128; i += gthreads) { const int lg = i >> 14, d = (i >> 7) & 127, c = i & 127; poolwT[i] = f2bf(PIN(I_POOLW)[((size_t)lg * 128 + c) * 128 + d]); }
}

DEVINL void item_prep(const Params& p, unsigned char* lds, int tt, int l, int z) {
    LAUNDER_PTRS;
    const int tid = (int)(threadIdx.x + z), lane = tid & 63, w = tid >> 6, fr = lane & 15, fq = lane >> 4;
    const int m0 = tt * 16;
    const bf16_t* proj = (const bf16_t*)(PWS + WS_PROJ);
    const float* mu = PIN(I_MU) + l * SHW; const float* stsh = PIN(I_SSHIFT) + (size_t)l * 128 * SHW;
    bf16_t* Aw = (bf16_t*)lds; bf16_t* Aa = Aw + 16 * 72;
    for (int e = tid; e < 2048; e += 512) {
        const int tok = e >> 7, j = e & 127, m = m0 + tok, c = 3072 + j;
        const float cur = bf2f(proj[(size_t)m * DINP + c]);
        float prv;
        if (m < MP) prv = (m & 2047) ? bf2f(proj[(size_t)(m - 1) * DINP + c]) : 0.f;
        else { const int ms = m - MP; prv = (ms & 7) ? bf2f(proj[(size_t)(m - 1) * DINP + c]) : stsh[(ms >> 3) * SHW + c]; }
        const float x = cur + (prv - cur) * mu[c];
        if (j < 64) Aw[tok * 72 + j] = f2bf(tanhf(x)); else Aa[tok * 72 + (j - 64)] = f2bf(x);
    }
    __syncthreads();
    bf16x8 tw[2], ta[2];
#pragma unroll
    for (int ks = 0; ks < 2; ++ks) { tw[ks] = *(const bf16x8*)(Aw + fr * 72 + ks * 32 + fq * 8); ta[ks] = *(const bf16x8*)(Aa + fr * 72 + ks * 32 + fq * 8); }
    const int m = m0 + fr;
    const bf16_t* prow = proj + (size_t)m * DINP;
    const bf16_t* pprev = nullptr; const float* sprev = nullptr;
    if (m < MP) { if (m & 2047) pprev = prow - DINP; }
    else { const int ms = m - MP; if (ms & 7) pprev = prow - DINP; else sprev = stsh + (ms >> 3) * SHW; }
    const bf16_t* wupT = (const bf16_t*)(PWS + WS_WUPT) + (size_t)l * 1024 * 64; const bf16_t* aupT = (const bf16_t*)(PWS + WS_AUPT) + (size_t)l * 1024 * 64;
    const float* w0 = PIN(I_W0) + l * 1024; const float* a0 = PIN(I_A0) + l * 1024; const float* k_k = PIN(I_KK) + l * 1024; const float* k_a = PIN(I_KA) + l * 1024; const float* r_k = PIN(I_RK) + l * 1024;
    float* sc = (float*)(PWS + WS_SCAN); float* rkb = (float*)(PWS + WS_RKB);
#define LDPREV(c) (pprev ? ld4bf(pprev + (c)) : (sprev ? *(const f32x4*)(sprev + (c)) : (f32x4){0.f, 0.f, 0.f, 0.f}))
    for (int hh = 0; hh < 2; ++hh) {
        const int h = w * 2 + hh;
        f32x4 aw[4], aa[4];
#pragma unroll
        for (int nt = 0; nt < 4; ++nt) {
            const int crow = h * 64 + nt * 16 + fr;
            aw[nt] = (f32x4){0.f, 0.f, 0.f, 0.f}; aa[nt] = (f32x4){0.f, 0.f, 0.f, 0.f};
#pragma unroll
            for (int ks = 0; ks < 2; ++ks) {
                const bf16x8 fw = *(const bf16x8*)(wupT + (size_t)crow * 64 + ks * 32 + fq * 8), fa = *(const bf16x8*)(aupT + (size_t)crow * 64 + ks * 32 + fq * 8);
                aw[nt] = mfma16(fw, tw[ks], aw[nt]); aa[nt] = mfma16(fa, ta[ks], aa[nt]);
            }
        }
        f32x4 kkq[4], aq[4]; float ss = 0.f, rk = 0.f;
#pragma unroll
        for (int nt = 0; nt < 4; ++nt) {
            const int c = h * 64 + nt * 16 + fq * 4;
            const f32x4 cr = ld4bf(prow + c), ck = ld4bf(prow + 1024 + c), cv = ld4bf(prow + 2048 + c);
            const f32x4 pr = LDPREV(c), pk = LDPREV(1024 + c), pv = LDPREV(2048 + c);
            const f32x4 r = cr + (pr - cr) * *(const f32x4*)(mu + c), k = ck + (pk - ck) * *(const f32x4*)(mu + 1024 + c), v = cv + (pv - cv) * *(const f32x4*)(mu + 2048 + c);
            const f32x4 wp = aw[nt] + *(const f32x4*)(w0 + c), ap = aa[nt] + *(const f32x4*)(a0 + c);
            f32x4 wv, av;
#pragma unroll
            for (int e = 0; e < 4; ++e) {
                const float x = -wp[e]; const float sp = fmaxf(x, 0.f) + __logf(1.f + __expf(-fabsf(x)));
                wv[e] = __expf(-__expf(-sp - 0.5f)); av[e] = 1.f / (1.f + __expf(-ap[e]));
            }
            const f32x4 kk = k * *(const f32x4*)(k_k + c);
            ss += kk[0] * kk[0] + kk[1] * kk[1] + kk[2] * kk[2] + kk[3] * kk[3];
            const f32x4 kp = k * (1.f + (av - 1.f) * *(const f32x4*)(k_a + c));
            const f32x4 rkv = r * kp * *(const f32x4*)(r_k + c);
            rk += rkv[0] + rkv[1] + rkv[2] + rkv[3];
            float* o = sc + (size_t)m * 1024 + c;
            *(f32x4*)(o) = wv; *(f32x4*)(o + 3 * SCAN_STRIDE) = kp; *(f32x4*)(o + 4 * SCAN_STRIDE) = r; *(f32x4*)(o + 5 * SCAN_STRIDE) = v;
            kkq[nt] = kk; aq[nt] = av;
        }
        ss = xq_sum(ss); rk = xq_sum(rk);
        const float inv = rsqrtf(fmaxf(ss, 1e-12f));
#pragma unroll
        for (int nt = 0; nt < 4; ++nt) {
            const int c = h * 64 + nt * 16 + fq * 4;
            const f32x4 kn = kkq[nt] * inv; float* o = sc + (size_t)m * 1024 + c;
            *(f32x4*)(o + SCAN_STRIDE) = -kn; *(f32x4*)(o + 2 * SCAN_STRIDE) = kn * aq[nt];
        }
        if (fq == 0) rkb[m * 16 + h] = rk;
    }
#undef LDPREV
    __syncthreads();
}

DEVINL void item_pool(const Params& p, unsigned char* lds, int pt, int g, int l, int z) {
    LAUNDER_PTRS;
    const int tid = (int)(threadIdx.x + z), lane = tid & 63, w = tid >> 6, fr = lane & 15, fq = lane >> 4;
    const int m0 = pt * 64, win = 2 << g;
    const bf16_t* proj = (const bf16_t*)(PWS + WS_PROJ); bf16_t* cat = (bf16_t*)(PWS + WS_CAT);
    const float* stp = PIN(I_SPOOL) + (size_t)l * 128 * 15 * 512;
    bf16_t* Ap = (bf16_t*)lds;
    {
        const int col = tid & 127, gc = g * 128 + col, tb = (tid >> 7) * 16;
        for (int i = 0; i < 16; ++i) {
            const int tok = tb + i, m = m0 + tok;
            float sum = 0.f, u0 = 0.f, cnt;
            if (m < MP) {
                const int t = m & 2047; const int nv = min(t + 1, win); cnt = (float)nv;
                for (int d = 0; d < nv; ++d) { const float u = bf2f(proj[(size_t)(m - d) * DINP + C_UB + gc]); sum += u; if (d == 0) u0 = u; }
            } else {
                const int ms = m - MP, t = ms & 7, b = ms >> 3; cnt = (float)win;
                for (int d = 0; d < win; ++d) { const float u = (t - d >= 0) ? bf2f(proj[(size_t)(m - d) * DINP + C_UB + gc]) : stp[(size_t)(b * 15 + 15 + t - d) * 512 + gc]; sum += u; if (d == 0) u0 = u; }
            }
            Ap[tok * 136 + col] = f2bf(sum / cnt - u0);
        }
    }
    __syncthreads();
    const bf16_t* pw = (const bf16_t*)(PWS + WS_POOLWT) + (size_t)(l * 4 + g) * 128 * 128;
    bf16x8 fa[4];
#pragma unroll
    for (int ks = 0; ks < 4; ++ks) fa[ks] = *(const bf16x8*)(pw + (size_t)(w * 16 + fr) * 128 + ks * 32 + fq * 8);
    const int d0 = g * 128 + w * 16 + fq * 4;
    const f32x4 scl = *(const f32x4*)(PIN(I_POOLS) + l * 512 + d0);
#pragma unroll
    for (int mt = 0; mt < 4; ++mt) {
        f32x4 acc = {0.f, 0.f, 0.f, 0.f};
#pragma unroll
        for (int ks = 0; ks < 4; ++ks) acc = mfma16(fa[ks], *(const bf16x8*)(Ap + (mt * 16 + fr) * 136 + ks * 32 + fq * 8), acc);
        const int m = m0 + mt * 16 + fr;
        const f32x4 gb = ld4bf(proj + (size_t)m * DINP + C_GB + d0);
        f32x4 o;
#pragma unroll
        for (int e = 0; e < 4; ++e) o[e] = acc[e] * scl[e] * siluf(gb[e]);
        st4bf(cat + (size_t)m * DM + 1024 + d0, o);
    }
    __syncthreads();
}

DEVINL void item_chunk(const Params& p, unsigned char* lds, int ck, int g, int l, int z) {
    LAUNDER_PTRS;
    const int tid = (int)(threadIdx.x + z), lane = tid & 63, w = tid >> 6, fr = lane & 15, fq = lane >> 4;
    const int m0 = ck * 128; const bool smp = ck >= 64;
    const bf16_t* proj = (const bf16_t*)(PWS + WS_PROJ); bf16_t* cat = (bf16_t*)(PWS + WS_CAT);
    bf16_t* vnT = (bf16_t*)lds;
    bf16_t* Aws = vnT + 128 * 136;
    float* stats = (float*)(Aws + 128 * 136);
    const int tok = tid >> 2, part = tid & 3, m = m0 + tok;
    {
        const bf16_t* vp = proj + (size_t)m * DINP + C_VC + part * 128;
        float s = 0.f, q = 0.f;
#pragma unroll
        for (int i = 0; i < 32; ++i) { const f32x4 v = ld4bf(vp + i * 4); s += v[0] + v[1] + v[2] + v[3]; q += v[0] * v[0] + v[1] * v[1] + v[2] * v[2] + v[3] * v[3]; }
        s += __shfl_xor(s, 1); s += __shfl_xor(s, 2); q += __shfl_xor(q, 1); q += __shfl_xor(q, 2);
        const float mean = s * (1.f / 512.f), var = fmaxf(q * (1.f / 512.f) - mean * mean, 0.f);
        if (part == 0) { stats[tok * 2] = mean; stats[tok * 2 + 1] = rsqrtf(var + 1e-5f); }
    }
    __syncthreads();
    {
        const float mean = stats[tok * 2], rstd = stats[tok * 2 + 1];
        const float* lng = PIN(I_GLNG) + l * 512 + g * 128 + part * 32;
        const bf16_t* vp = proj + (size_t)m * DINP + C_VC + g * 128 + part * 32;
#pragma unroll
        for (int i = 0; i < 8; ++i) {
            const f32x4 v = ld4bf(vp + i * 4); const f32x4 gg = *(const f32x4*)(lng + i * 4);
            f32x4 vn;
#pragma unroll
            for (int e = 0; e < 4; ++e) { vn[e] = (v[e] - mean) * rstd * gg[e]; vnT[(part * 32 + i * 4 + e) * 136 + tok] = f2bf(vn[e]); }
            if (smp) *(f32x4*)(POUT + O_SV + ((size_t)l * 1024 + (m - MP)) * 512 + g * 128 + part * 32 + i * 4) = vn;
        }
        const float* wsg = PIN(I_GWS) + (size_t)(l * 4 + g) * 128 * 128;
        const int t = tok;
#pragma unroll
        for (int i = 0; i < 8; ++i) {
            const int s0 = part * 32 + i * 4;
            f32x4 a;
            if (!smp) { a = *(const f32x4*)(wsg + (size_t)t * 128 + s0);
#pragma unroll
                for (int e = 0; e < 4; ++e) a[e] = (s0 + e <= t) ? a[e] : 0.f; }
            else {
#pragma unroll
                for (int e = 0; e < 4; ++e) { const int s = s0 + e; a[e] = ((s >> 3) == (t >> 3) && (s & 7) <= (t & 7)) ? wsg[(t & 7) * 128 + (s & 7)] : 0.f; } }
            st4bf(Aws + t * 136 + s0, a);
        }
    }
    __syncthreads();
    bf16x8 fa[4];
#pragma unroll
    for (int ks = 0; ks < 4; ++ks) fa[ks] = *(const bf16x8*)(vnT + (w * 16 + fr) * 136 + ks * 32 + fq * 8);
    const int c0 = g * 128 + w * 16 + fq * 4;
    const float* gbias = PIN(I_GB) + (l * 4 + g) * 128;
#pragma unroll
    for (int tt = 0; tt < 8; ++tt) {
        f32x4 acc = {0.f, 0.f, 0.f, 0.f};
#pragma unroll
        for (int ks = 0; ks < 4; ++ks) {
            const bool need = smp ? (ks == (tt >> 1)) : (ks <= (tt >> 1));
            if (need) acc = mfma16(fa[ks], *(const bf16x8*)(Aws + (tt * 16 + fr) * 136 + ks * 32 + fq * 8), acc);
        }
        const int t = tt * 16 + fr, mm = m0 + t;
        const float bias = gbias[smp ? (t & 7) : t];
        const f32x4 uc = ld4bf(proj + (size_t)mm * DINP + C_UC + c0), gc = ld4bf(proj + (size_t)mm * DINP + C_GC + c0);
        f32x4 o;
#pragma unroll
        for (int e = 0; e < 4; ++e) o[e] = uc[e] * (acc[e] + bias) * siluf(gc[e]);
        st4bf(cat + (size_t)mm * DM + 1536 + c0, o);
    }
    __syncthreads();
}

DEVINL void phase2a(const Params& p, unsigned char* lds, int l, int z) {
    LAUNDER_PTRS;
    const int G = gridDim.x, bid = (int)(blockIdx.x + z), tid = (int)(threadIdx.x + z);
    for (int it = bid; it < 288 + 576 + 576; it += G) {
        if (it < 288) item_chunk(p, lds, it >> 2, it & 3, l, z);
        else if (it < 864) { const int j = it - 288; item_pool(p, lds, j >> 2, j & 3, l, z); }
        else item_prep(p, lds, it - 864, l, z);
    }
    const bf16_t* proj = (const bf16_t*)(PWS + WS_PROJ);
    const int gtid = bid * 512 + tid, gthreads = G * 512;
    for (int i = gtid; i < 132 * SHW; i += gthreads) {
        const int b = i / SHW, c = i % SHW;
        if (b < 4) POUT[O_PSHIFT + ((size_t)l * 4 + b) * SHW + c] = bf2f(proj[(size_t)(b * 2048 + 2047) * DINP + c]);
        else POUT[O_SSHIFT + ((size_t)l * 128 + (b - 4)) * SHW + c] = bf2f(proj[(size_t)(MP + (b - 4) * 8 + 7) * DINP + c]);
    }
    for (int i = gtid; i < 132 * 15 * 512; i += gthreads) {
        const int b = i / (15 * 512), r = (i / 512) % 15, c = i % 512;
        if (b < 4) POUT[O_PPOOL + (((size_t)l * 4 + b) * 15 + r) * 512 + c] = bf2f(proj[(size_t)(b * 2048 + 2033 + r) * DINP + C_UB + c]);
        else { const int bb = b - 4;
            POUT[O_SPOOL + (((size_t)l * 128 + bb) * 15 + r) * 512 + c] = (r < 7) ? PIN(I_SPOOL)[(((size_t)l * 128 + bb) * 15 + 8 + r) * 512 + c] : bf2f(proj[(size_t)(MP + bb * 8 + (r - 7)) * DINP + C_UB + c]); }
    }
}
#define SCAN_STEP(S, sp, irow, yv) do { \
        const f32x4 wv_ = *(const f32x4*)((sp) + kq * 4), nk_ = *(const f32x4*)((sp) + 64 + kq * 4), bb_ = *(const f32x4*)((sp) + 128 + kq * 4), kv_ = *(const f32x4*)((sp) + 192 + kq * 4), rv_ = *(const f32x4*)((sp) + 256 + kq * 4); \
        const float vv_ = (sp)[320 + (irow)]; \
        float sa_ = S[0] * nk_[0] + S[1] * nk_[1] + S[2] * nk_[2] + S[3] * nk_[3]; sa_ = allreduce16(sa_); \
        S = S * wv_ + sa_ * bb_ + vv_ * kv_; \
        float y_ = S[0] * rv_[0] + S[1] * rv_[1] + S[2] * rv_[2] + S[3] * rv_[3]; yv = allreduce16(y_); } while (0)

DEVINL void scan_prompt(const Params& p, unsigned char* lds, int it, int l, int z) {
    LAUNDER_PTRS;
    const int tid = (int)(threadIdx.x + z), w = tid >> 6, lane = tid & 63;
    const int v = (it & 7) * 32 + (it >> 3), bh = v >> 2, q4 = v & 3, b = bh >> 4, h = bh & 15, hc = h * 64;
    float* buf = (float*)lds;
    const float* sc = (const float*)(PWS + WS_SCAN); float* ybuf = (float*)(PWS + WS_Y);
    const size_t rowbase = (size_t)b * 2048;
    if (w >= 4) {
        const int lt = tid - 256, t0 = lt >> 4, f4 = lt & 15;
        f32x4 ld[12];
        const float* gp = sc + (rowbase + t0) * 1024 + hc + f4 * 4; float* lp = buf + t0 * 384 + f4 * 4;
#define LD_ISSUE(c) do { _Pragma("unroll") for (int vec = 0; vec < 6; ++vec) _Pragma("unroll") for (int q = 0; q < 2; ++q) ld[vec * 2 + q] = *(const f32x4*)(gp + (size_t)vec * SCAN_STRIDE + (size_t)((c) * 32 + q * 16) * 1024); } while (0)
#define LD_WRITE(slot) do { _Pragma("unroll") for (int vec = 0; vec < 6; ++vec) _Pragma("unroll") for (int q = 0; q < 2; ++q) *(f32x4*)(lp + (slot) * 12288 + q * 16 * 384 + vec * 64) = ld[vec * 2 + q]; } while (0)
        LD_ISSUE(0); LD_WRITE(0); LD_ISSUE(1);
        __syncthreads();
        for (int c = 0; c < 64; ++c) {
            if (c + 1 < 64) LD_WRITE((c + 1) & 1);
            if (c + 2 < 64) LD_ISSUE(c + 2);
            __syncthreads();
        }
#undef LD_ISSUE
#undef LD_WRITE
    } else {
        const int il = lane >> 4, kq = lane & 15, i = q4 * 16 + w * 4 + il;
        f32x4 S = {0.f, 0.f, 0.f, 0.f};
        __syncthreads();
        for (int c = 0; c < 64; ++c) {
            const float* cb = buf + (c & 1) * 12288;
            float* yp = ybuf + (rowbase + c * 32) * 1024 + hc + i;
#pragma unroll 4
            for (int s = 0; s < 32; ++s) {
                float y; SCAN_STEP(S, cb + s * 384, i, y);
                if (kq == 0) yp[(size_t)s * 1024] = y;
            }
            __syncthreads();
        }
        *(f32x4*)(POUT + O_PWKV + ((((size_t)l * 4 + b) * 16 + h) * 64 + i) * 64 + kq * 4) = S;
    }
}

DEVINL void scan_sample(const Params& p, unsigned char* lds, int it, int l, int z) {
    LAUNDER_PTRS;
    const int tid = (int)(threadIdx.x + z), w = tid >> 6, lane = tid & 63, il = lane >> 4, kq = lane & 15;
    const int b = it >> 4, h = it & 15, hc = h * 64;
    float* buf = (float*)lds;
    const float* sc = (const float*)(PWS + WS_SCAN); float* ybuf = (float*)(PWS + WS_Y);
    const size_t row0 = (size_t)MP + b * 8;
    for (int idx = tid; idx < 768; idx += 512) {
        const int t = idx / 96, rem = idx % 96, vec = rem >> 4, f4 = rem & 15;
        *(f32x4*)(buf + t * 384 + vec * 64 + f4 * 4) = *(const f32x4*)(sc + (size_t)vec * SCAN_STRIDE + (row0 + t) * 1024 + hc + f4 * 4);
    }
    const int ia = w * 4 + il, ib = ia + 32;
    const size_t sbase = (((size_t)l * 128 + b) * 16 + h) * 4096;
    f32x4 Sa = *(const f32x4*)(PIN(I_SWKV) + sbase + ia * 64 + kq * 4), Sb = *(const f32x4*)(PIN(I_SWKV) + sbase + ib * 64 + kq * 4);
    __syncthreads();
#pragma unroll
    for (int s = 0; s < 8; ++s) {
        float ya, yb; SCAN_STEP(Sa, buf + s * 384, ia, ya); SCAN_STEP(Sb, buf + s * 384, ib, yb);
        if (kq == 0) { ybuf[(row0 + s) * 1024 + hc + ia] = ya; ybuf[(row0 + s) * 1024 + hc + ib] = yb; }
    }
    *(f32x4*)(POUT + O_SWKV + sbase + ia * 64 + kq * 4) = Sa; *(f32x4*)(POUT + O_SWKV + sbase + ib * 64 + kq * 4) = Sb;
    __syncthreads();
}

DEVINL void phase2b(const Params& p, unsigned char* lds, int l, int z) {
    const int G = gridDim.x, bid = (int)(blockIdx.x + z);
    for (int it = bid; it < 256; it += G) scan_prompt(p, lds, it, l, z);
    for (int it = bid; it < 2048; it += G) scan_sample(p, lds, it, l, z);
}

DEVINL void phase2c(const Params& p, int l, int z) {
    LAUNDER_PTRS;
    const int gtid = (int)(blockIdx.x + z) * 512 + (int)(threadIdx.x + z), gthreads = gridDim.x * 512;
    const float* ybuf = (const float*)(PWS + WS_Y); const float* sv = (const float*)(PWS + WS_SCAN) + 5 * SCAN_STRIDE; const float* rkb = (const float*)(PWS + WS_RKB);
    const bf16_t* proj = (const bf16_t*)(PWS + WS_PROJ); bf16_t* cat = (bf16_t*)(PWS + WS_CAT);
    const float* lg = PIN(I_LNXG) + l * 1024; const float* lb = PIN(I_LNXB) + l * 1024;
    for (int i = gtid; i < MTOT * 256; i += gthreads) {
        const int m = i >> 8, c = (i & 255) * 4, h = c >> 6;
        const f32x4 y = *(const f32x4*)(ybuf + (size_t)m * 1024 + c);
        const float mean = allreduce16(y[0] + y[1] + y[2] + y[3]) * (1.f / 64.f);
        const f32x4 d = y - mean;
        const float var = allreduce16(d[0] * d[0] + d[1] * d[1] + d[2] * d[2] + d[3] * d[3]) * (1.f / 64.f);
        const float rs = rsqrtf(var + 64e-5f);
        const f32x4 vv = *(const f32x4*)(sv + (size_t)m * 1024 + c); const float bon = rkb[m * 16 + h];
        const f32x4 ga = ld4bf(proj + (size_t)m * DINP + C_GA + c);
        const f32x4 g4 = *(const f32x4*)(lg + c), b4 = *(const f32x4*)(lb + c);
        f32x4 o;
#pragma unroll
        for (int e = 0; e < 4; ++e) o[e] = (d[e] * rs * g4[e] + b4[e] + bon * vv[e]) * siluf(ga[e]);
        st4bf(cat + (size_t)m * DM + c, o);
    }
}

DEVINL void phase_final(const Params& p, int z) {
    LAUNDER_PTRS;
    const int gtid = (int)(blockIdx.x + z) * 512 + (int)(threadIdx.x + z), gthreads = gridDim.x * 512;
    const float* xf = (const float*)(PWS + WS_XF); const float* ssq = (const float*)(PWS + WS_SSQ) + 4 * MTOT; const float* fg = PIN(I_FNORMG);
    for (int i = gtid; i < MTOT * 512; i += gthreads) {
        const int m = i >> 9, c = (i & 511) * 4;
        const float rs = rsqrtf(ssq[m] * (1.f / 2048.f) + 1e-6f);
        *(f32x4*)(POUT + (size_t)m * DM + c) = *(const f32x4*)(xf + (size_t)m * DM + c) * rs * *(const f32x4*)(fg + c);
    }
}

#define FRESH_Z(z) int z; asm volatile("s_mov_b32 %0, 0" : "=s"(z))
__global__ void __launch_bounds__(512, 2) hybrid_fwd(Params p) {
    extern __shared__ __attribute__((aligned(16))) unsigned char lds[];
    cg::grid_group grid = cg::this_grid();
    { FRESH_Z(z); phase0(p, lds, z); }
    grid.sync();
    for (int l = 0; l < NL; ++l) {
        {
            FRESH_Z(z); LAUNDER_PTRS;
            pg8::Gemm g; g.A = (const bf16_t*)(PWS + WS_XB); g.Bt = (const bf16_t*)(PWS + WS_WINT) + (size_t)l * DINP * DM; g.M = MTOT; g.N = DINP; g.K = DM;
            pg8::StaticOrder S; S.init(MTOT, DINP, (int)gridDim.x, (int)(blockIdx.x + z));
            EpiProj E; E.O = (bf16_t*)(PWS + WS_PROJ); E.ssq = (const float*)(PWS + WS_SSQ) + l * MTOT;
            pg8::gemm_phase<EpiProj, pg8::StaticOrder, false>((PG8_LAS unsigned char*)lds, g, S, E, nullptr, z);
        }
        grid.sync();
        { FRESH_Z(z); phase2a(p, lds, l, z); }
        grid.sync();
        { FRESH_Z(z); phase2b(p, lds, l, z); }
        grid.sync();
        { FRESH_Z(z); phase2c(p, l, z); }
        grid.sync();
        {
            FRESH_Z(z); LAUNDER_PTRS;
            pg8::Gemm g; g.A = (const bf16_t*)(PWS + WS_CAT); g.Bt = (const bf16_t*)(PWS + WS_WOUTT) + (size_t)l * DM * DM; g.M = MTOT; g.N = DM; g.K = DM;
            pg8::StaticOrder S; S.init(MTOT, DM, (int)gridDim.x, (int)(blockIdx.x + z));
            EpiRes E; E.srcP = l == 0 ? PIN(I_XP) : (const float*)(PWS + WS_XF); E.srcS = l == 0 ? PIN(I_XS) : (const float*)(PWS + WS_XF) + (size_t)MP * DM;
            E.xf = (float*)(PWS + WS_XF); E.xb = (bf16_t*)(PWS + WS_XB); E.ssq_next = (float*)(PWS + WS_SSQ) + (l + 1) * MTOT;
            pg8::gemm_phase<EpiRes, pg8::StaticOrder, false>((PG8_LAS unsigned char*)lds, g, S, E, nullptr, z);
        }
        grid.sync();
    }
    { FRESH_Z(z); phase_final(p, z); }
}

extern "C" void kernel_launch(void* const* d_in, const int* in_sizes, int n_in, void* d_out, int out_size, void* d_ws, size_t ws_size, hipStream_t stream) {
    static int grid = 0;
    if (grid == 0) {
        if (n_in != 24 || (size_t)out_size != O_END || ws_size < WS_END) { fprintf(stderr, "kernel_launch: unexpected shapes (n_in %d out %d ws %zu, need ws >= %zu)\n", n_in, out_size, ws_size, (size_t)WS_END); grid = -1; return; }
        int dev = 0, cus = 0, per_cu = 0;
        (void)hipGetDevice(&dev); (void)hipDeviceGetAttribute(&cus, hipDeviceAttributeMultiprocessorCount, dev);
        if (hipFuncSetAttribute((const void*)hybrid_fwd, hipFuncAttributeMaxDynamicSharedMemorySize, LDS_BYTES) != hipSuccess) { fprintf(stderr, "kernel_launch: hipFuncSetAttribute failed\n"); grid = -1; return; }
        if (hipOccupancyMaxActiveBlocksPerMultiprocessor(&per_cu, (const void*)hybrid_fwd, 512, LDS_BYTES) != hipSuccess || per_cu < 1) { fprintf(stderr, "kernel_launch: occupancy query says %d blocks per CU\n", per_cu); per_cu = 1; }
        (void)hipGetLastError();
        grid = cus;
        if (grid > 256) grid = 256;
    }
    if (grid < 0) return;
    Params p{};
    for (int i = 0; i < 24; ++i) p.in[i] = (const float*)d_in[i];
    p.out = (float*)d_out; p.ws = (unsigned char*)d_ws;
    void* args[] = {&p};
    hipError_t e = hipLaunchCooperativeKernel((const void*)hybrid_fwd, dim3(grid), dim3(512), args, LDS_BYTES, stream);
    if (e != hipSuccess) fprintf(stderr, "kernel_launch: cooperative launch failed: %s (grid %d)\n", hipGetErrorString(e), grid);
}
```

```cpp
#include <hip/hip_runtime.h>
#include <hip/hip_cooperative_groups.h>
#include <cstdio>
namespace cg = cooperative_groups;
namespace pg8 {
#define PG8_LAS __attribute__((address_space(3)))
typedef unsigned short bf16_t;
typedef short bf16x8 __attribute__((ext_vector_type(8)));
typedef float f32x4 __attribute__((ext_vector_type(4)));
typedef unsigned u32x4 __attribute__((ext_vector_type(4)));
constexpr int BM = 256, BK = 64, HALF = 128, HTB = HALF * BK * 2  , STAGE_BYTES = 8 * HTB, NXCD = 8, WGM = 8;

__host__ __device__ __forceinline__ int lds_byte(int r, int c) { const int st = (r >> 4) * 2 + (c >> 5), rr = r & 15, cc = c & 31, ob = rr * 64 + cc * 2; return st * 1024 + (ob ^ (((ob >> 9) & 1) << 5)); }
__host__ __device__ __forceinline__ void stage_rc(int b, int& R, int& C) { const int st = b / 1024, sb = b % 1024, swz = sb ^ (((sb >> 9) & 1) << 5); R = (st >> 1) * 16 + swz / 64; C = (st & 1) * 32 + (swz % 64) / 2; }
__host__ __device__ __forceinline__ int perm32(int rho) { const int n = rho >> 4, i = rho & 15; return 8 * (i >> 2) + 4 * n + (i & 3); }

struct Unit { int pm, pn, half; };
struct Gemm { const bf16_t* A; const bf16_t* Bt; int M, N, K; };

struct StaticOrder {
    int nM, nN, nwg, G, c;
    __host__ __device__ void init(int M, int N, int G_, int c_) { nM = M / BM; nN = N / BM; nwg = nM * nN; G = G_; c = c_; }
    __host__ __device__ bool next(int i, Unit& u) const {
        const long L = (long)i * G + c; if (L >= nwg) return false;
        int wgid = (int)L; { const int q = nwg / NXCD, r = nwg % NXCD, xcd = wgid % NXCD, off = wgid / NXCD; wgid = (xcd < r ? xcd * (q + 1) : r * (q + 1) + (xcd - r) * q) + off; }
        const int nig = WGM * nN, gid = wgid / nig, fm = gid * WGM, gsz = (nM - fm) < WGM ? (nM - fm) : WGM;
        u.pm = fm + ((wgid % nig) % gsz); u.pn = (wgid % nig) / gsz; u.half = 0; return true;
    }
    __device__ __forceinline__ void a_ready(const Unit&) const {}
    __device__ __forceinline__ void done(const Unit&) const {}
};

template <class Epi, class Sched, bool STAMP = false>
__device__ __forceinline__ void gemm_phase(PG8_LAS unsigned char* lds, const Gemm g, const Sched& S, const Epi& E, unsigned long long* stamps, int zz) {
    const int tid = zz, wid = __builtin_amdgcn_readfirstlane(tid >> 6), lane = tid & 63, wr = wid >> 2, wc = wid & 3, fr = lane & 15, fq = lane >> 4;
    const int K = g.K, nt = K / BK;
    int ts_lo = 0, ts_hi = 0, nts = 0; const unsigned long long rt_entry = STAMP ? (unsigned long long)wall_clock64() : 0ull;
#define PG8_STAMP() do { if (STAMP && wid == 0 && nts < 64) { const unsigned long long _c = (unsigned long long)clock64(); \
        ts_lo = (lane == nts) ? (int)(unsigned)_c : ts_lo; ts_hi = (lane == nts) ? (int)(unsigned)(_c >> 32) : ts_hi; ++nts; } } while (0)
    PG8_STAMP();
    unsigned voffA[2], voffB[2];
#pragma unroll
    for (int i = 0; i < 2; ++i) { int R, C; stage_rc(tid * 16 + i * 8192, R, C); const int Rb = Epi::PERM ? ((R & ~31) + perm32(R & 31)) : R;
        voffA[i] = (unsigned)(R * K + C) * 2u; voffB[i] = (unsigned)(Rb * K + C) * 2u; }
    const size_t kstep = (size_t)(BK * 2);
    const size_t hstep = (size_t)HALF * K * 2;
    const size_t tstep = 2 * hstep;
    const unsigned ldsw = (unsigned)wid * 1024u;
    const int aoff = lds_byte(wr * 64 + fr, fq * 8), boff = lds_byte(wc * 32 + fr, fq * 8);
#define PG8_SA(b, h) (((b) * 2 + (h)) * HTB)
#define PG8_SB(b, h) ((4 + (b) * 2 + (h)) * HTB)
#define PG8_STAGE(bufoff, gbase, voff) do { _Pragma("unroll") for (int _i = 0; _i < 2; ++_i) \
        __builtin_amdgcn_global_load_lds((const unsigned*)((const char*)(gbase) + (voff)[_i]), (PG8_LAS unsigned*)(lds + (bufoff) + ldsw + _i * 8192), 16, 0, 0); } while (0)
#define PG8_LDA(dst, b, h) do { _Pragma("unroll") for (int m = 0; m < 4; ++m) _Pragma("unroll") for (int k = 0; k < 2; ++k) dst[m][k] = *(const PG8_LAS bf16x8*)(lds + PG8_SA(b, h) + aoff + m * 2048 + k * 1024); } while (0)
#define PG8_LDB(dst, b, h) do { _Pragma("unroll") for (int n = 0; n < 2; ++n) _Pragma("unroll") for (int k = 0; k < 2; ++k) dst[n][k] = *(const PG8_LAS bf16x8*)(lds + PG8_SB(b, h) + boff + n * 2048 + k * 1024); } while (0)
#define PG8_MMA(ai, bj, At, Bt) do { __builtin_amdgcn_s_setprio(1); _Pragma("unroll") for (int m = 0; m < 4; ++m) _Pragma("unroll") for (int n = 0; n < 2; ++n) _Pragma("unroll") for (int k = 0; k < 2; ++k) \
        acc[ai][bj][m][n] = __builtin_amdgcn_mfma_f32_16x16x32_bf16(Bt[n][k], At[m][k], acc[ai][bj][m][n], 0, 0, 0); __builtin_amdgcn_s_setprio(0); } while (0)
#define PG8_WAIT_V(n) asm volatile("s_waitcnt vmcnt(" #n ")" ::: "memory")
#define PG8_WAIT_L(n) asm volatile("s_waitcnt lgkmcnt(" #n ")" ::: "memory")
#define PG8_BAR __builtin_amdgcn_s_barrier()
#define PG8_SCHED __builtin_amdgcn_sched_barrier(0)
    Unit cur, nxt; int ui = 0;
    if (!S.next(0, cur)) return;
    f32x4 acc[2][2][4][2];
#pragma unroll
    for (int a = 0; a < 2; ++a)
#pragma unroll
        for (int b = 0; b < 2; ++b)
#pragma unroll
            for (int m = 0; m < 4; ++m)
#pragma unroll
                for (int n = 0; n < 2; ++n) acc[a][b][m][n] = (f32x4){0.f, 0.f, 0.f, 0.f};
    bf16x8 At[4][2], B0[2][2], B1[2][2];
    const char* cA = (const char*)g.A + (size_t)cur.pm * tstep; const char* cB = (const char*)g.Bt + (size_t)cur.pn * tstep;
    S.a_ready(cur);
    PG8_STAGE(PG8_SB(0, 0), cB, voffB); PG8_STAGE(PG8_SA(0, 0), cA, voffA); PG8_STAGE(PG8_SB(0, 1), cB + hstep, voffB); PG8_STAGE(PG8_SA(0, 1), cA + hstep, voffA);
    if (wr == 1) PG8_BAR;
    PG8_WAIT_V(4); PG8_BAR;
    PG8_STAGE(PG8_SB(1, 0), cB + kstep, voffB); PG8_STAGE(PG8_SA(1, 0), cA + kstep, voffA); PG8_STAGE(PG8_SB(1, 1), cB + hstep + kstep, voffB);
    PG8_WAIT_V(6); PG8_BAR;
    PG8_STAMP();
    for (;;) {
        const bool has_next = S.next(ui + 1, nxt);
        const char* nA = has_next ? (const char*)g.A + (size_t)nxt.pm * tstep : cA; const char* nB = has_next ? (const char*)g.Bt + (size_t)nxt.pn * tstep : cB;
        for (int t = 0; t < nt; t += 2) {
            const bool last = (t == nt - 2);
            const char* a1 = cA + (size_t)(t + 1) * kstep;
            const char* a2 = last ? nA : cA + (size_t)(t + 2) * kstep; const char* b2 = last ? nB : cB + (size_t)(t + 2) * kstep;
            const char* a3 = a2 + kstep; const char* b3 = b2 + kstep;
            if (last && has_next) S.a_ready(nxt);
            PG8_LDB(B0, 0, 0); PG8_SCHED; PG8_LDA(At, 0, 0); PG8_STAGE(PG8_SA(1, 1), a1 + hstep, voffA);
            PG8_WAIT_L(8); PG8_BAR; PG8_WAIT_L(0); if (cur.half != 2) PG8_MMA(0, 0, At, B0); PG8_BAR; PG8_SCHED;
            PG8_LDB(B1, 0, 1); PG8_STAGE(PG8_SB(0, 0), b2, voffB);
            PG8_BAR; PG8_WAIT_L(0); if (cur.half != 2) PG8_MMA(0, 1, At, B1); PG8_BAR;
            PG8_LDA(At, 0, 1); PG8_STAGE(PG8_SA(0, 0), a2, voffA);
            PG8_BAR; PG8_WAIT_L(0); if (cur.half != 1) PG8_MMA(1, 0, At, B0); PG8_BAR; PG8_SCHED;
            PG8_STAGE(PG8_SB(0, 1), b2 + hstep, voffB);
            PG8_WAIT_V(6); PG8_BAR; if (cur.half != 1) PG8_MMA(1, 1, At, B1); PG8_BAR;
            PG8_LDB(B0, 1, 0); PG8_SCHED; PG8_LDA(At, 1, 0); PG8_STAGE(PG8_SA(0, 1), a2 + hstep, voffA);
            PG8_WAIT_L(8); PG8_BAR; PG8_WAIT_L(0); if (cur.half != 2) PG8_MMA(0, 0, At, B0); PG8_BAR; PG8_SCHED;
            PG8_LDB(B1, 1, 1); PG8_STAGE(PG8_SB(1, 0), b3, voffB);
            PG8_BAR; PG8_WAIT_L(0); if (cur.half != 2) PG8_MMA(0, 1, At, B1); PG8_BAR;
            PG8_LDA(At, 1, 1); PG8_STAGE(PG8_SA(1, 0), a3, voffA);
            PG8_BAR; PG8_WAIT_L(0); if (cur.half != 1) PG8_MMA(1, 0, At, B0); PG8_BAR; PG8_SCHED;
            PG8_STAGE(PG8_SB(1, 1), b3 + hstep, voffB);
            PG8_WAIT_V(6); PG8_BAR; if (cur.half != 1) PG8_MMA(1, 1, At, B1); PG8_BAR;
        }
        PG8_STAMP();
        if constexpr (!Epi::AFTER_DRAIN) { E(acc, cur, wr, wc, fr, fq); S.done(cur); }
        PG8_STAMP();
        if (!has_next) break;
#pragma unroll
        for (int a = 0; a < 2; ++a)
#pragma unroll
            for (int b = 0; b < 2; ++b)
#pragma unroll
                for (int m = 0; m < 4; ++m)
#pragma unroll
                    for (int n = 0; n < 2; ++n) acc[a][b][m][n] = (f32x4){0.f, 0.f, 0.f, 0.f};
        cur = nxt; cA = nA; cB = nB; ++ui;
    }
    PG8_WAIT_V(0);
    if (wr == 0) PG8_BAR;
    PG8_BAR;
    if constexpr (Epi::AFTER_DRAIN) { E.fused(acc, cur, wr, wc, fr, fq, lds, wid, lane); S.done(cur); }
    PG8_STAMP();
    if (STAMP && wid == 0) { stamps[lane] = lane < nts ? (((unsigned long long)(unsigned)ts_hi << 32) | (unsigned)ts_lo) : 0ull;
        if (lane == 62) stamps[62] = rt_entry; if (lane == 63) stamps[63] = (unsigned long long)wall_clock64(); }
#undef PG8_STAMP
#undef PG8_SA
#undef PG8_SB
#undef PG8_STAGE
#undef PG8_LDA
#undef PG8_LDB
#undef PG8_MMA
#undef PG8_WAIT_V
#undef PG8_WAIT_L
#undef PG8_BAR
#undef PG8_SCHED
}
}
using pg8::bf16_t; using pg8::bf16x8; using pg8::f32x4; using pg8::u32x4;
typedef unsigned u32x2 __attribute__((ext_vector_type(2)));
#define DEVINL __device__ __forceinline__
#ifndef REP_CH
#define REP_CH 1
#endif
#ifndef REP_PL
#define REP_PL 1
#endif
#ifndef REP_PR1
#define REP_PR1 1
#endif
#ifndef REP_PR2
#define REP_PR2 1
#endif
#ifndef REP_SP
#define REP_SP 1
#endif
#ifndef REP_PS
#define REP_PS 1
#endif
#ifndef REP_PR
#define REP_PR 1
#endif
DEVINL int mk_tid(int wv, int z) { int lane; asm volatile("v_mbcnt_lo_u32_b32 %0, -1, 0\n\tv_mbcnt_hi_u32_b32 %0, -1, %0" : "=v"(lane)); return (wv + z) * 64 + lane; }
#define PIN(i) (p.in[(i) + z])
#define PWS ws_
#define POUT out_
#define LAUNDER_PTRS unsigned char* ws_ = p.ws; float* out_ = p.out; asm volatile("" : "+s"(ws_), "+s"(out_))

constexpr int DM = 2048, MTOT = 9216, MP = 8192, DIN = 6784, DINP = 6912, NL = 4, SHW = 3200;
constexpr int C_GA = 3200, C_UB = 4224, C_GB = 4736, C_UC = 5248, C_VC = 5760, C_GC = 6272;
constexpr size_t O_YP = 0, O_PSHIFT = 18874368, O_PWKV = 18925568, O_PPOOL = 19974144, O_SSHIFT = 20097024, O_SWKV = 21735424, O_SPOOL = 55289856, O_SV = 59222016, O_END = 61319168;
constexpr size_t SCAN_STRIDE = (size_t)MTOT * 1024;
constexpr size_t WS_WINT = 0;
constexpr size_t WS_WOUTT = WS_WINT + (size_t)NL * DINP * DM * 2;
constexpr size_t WS_XB = WS_WOUTT + (size_t)NL * DM * DM * 2;
constexpr size_t WS_XF = WS_XB + (size_t)MTOT * DM * 2;
constexpr size_t WS_PROJ = WS_XF + (size_t)MTOT * DM * 4;
constexpr size_t WS_CAT = WS_PROJ + (size_t)MTOT * DINP * 2;
constexpr size_t WS_SCAN = WS_CAT + (size_t)MTOT * DM * 2;
constexpr size_t WS_Y = WS_SCAN + 6 * SCAN_STRIDE * 4;
constexpr size_t WS_RKB = WS_Y + SCAN_STRIDE * 4;
constexpr size_t WS_SSQ = WS_RKB + (size_t)MTOT * 16 * 4 * 4;
constexpr size_t WS_WUPT = WS_SSQ + (size_t)5 * MTOT * 4;
constexpr size_t WS_AUPT = WS_WUPT + (size_t)NL * 1024 * 64 * 2;
constexpr size_t WS_POOLWT = WS_AUPT + (size_t)NL * 1024 * 64 * 2;
constexpr size_t WS_PREV = WS_POOLWT + (size_t)NL * 4 * 128 * 128 * 2;
constexpr size_t WS_ZROW = WS_PREV + (size_t)NL * 128 * SHW * 2;
constexpr size_t WS_BAR = WS_ZROW + 8192;
constexpr size_t WS_END = WS_BAR + 16384;
constexpr int REC = 6 * 64;
constexpr int LDS_BYTES = 131072 + 64;

struct Params { const float* in[24]; float* out; unsigned char* ws; };
enum { I_XP = 0, I_XS, I_SSHIFT, I_SWKV, I_SPOOL, I_NORMG, I_FNORMG, I_WIN, I_MU, I_W0, I_WUP, I_A0, I_AUP, I_KK, I_KA, I_RK, I_LNXG, I_LNXB, I_POOLW, I_POOLS, I_GLNG, I_GWS, I_GB, I_WOUT };

DEVINL unsigned cvt_pk(float lo, float hi) { unsigned r; asm("v_cvt_pk_bf16_f32 %0, %1, %2" : "=v"(r) : "v"(lo), "v"(hi)); return r; }
DEVINL bf16_t f2bf(float f) { unsigned u = __float_as_uint(f); u += 0x7FFFu + ((u >> 16) & 1u); return (bf16_t)(u >> 16); }
DEVINL float bf2f(bf16_t b) { return __uint_as_float(((unsigned)b) << 16); }
DEVINL f32x4 ld4bf(const bf16_t* p) { const u32x2 w = *(const u32x2*)p; f32x4 r; r[0] = __uint_as_float(w.x << 16); r[1] = __uint_as_float(w.x & 0xFFFF0000u); r[2] = __uint_as_float(w.y << 16); r[3] = __uint_as_float(w.y & 0xFFFF0000u); return r; }
DEVINL void st4bf(bf16_t* p, f32x4 v) { u32x2 w; w.x = cvt_pk(v[0], v[1]); w.y = cvt_pk(v[2], v[3]); *(u32x2*)p = w; }
DEVINL float siluf(float x) { return x * __builtin_amdgcn_rcpf(1.f + __expf(-x)); }
template <int CTRL> DEVINL float dpp_add(float x) { return x + __int_as_float(__builtin_amdgcn_update_dpp(0, __float_as_int(x), CTRL, 0xF, 0xF, false)); }
DEVINL float allreduce16(float x) { x = dpp_add<0x128>(x); x = dpp_add<0x124>(x); x = dpp_add<0x122>(x); x = dpp_add<0x121>(x); return x; }
DEVINL float xq_sum(float x) { x += __shfl_xor(x, 16); x += __shfl_xor(x, 32); return x; }
DEVINL float wave_sum(float x) { for (int o = 32; o > 0; o >>= 1) x += __shfl_xor(x, o); return x; }
DEVINL f32x4 mfma16(bf16x8 a, bf16x8 b, f32x4 c) { return __builtin_amdgcn_mfma_f32_16x16x32_bf16(a, b, c, 0, 0, 0); }


#define XB_TMO      128
#define XB_XCNT(j)  (256  + 64 * (j))
#define XB_XSUB(j)  (1280 + 64 * (j))
#define XB_XGEN(j)  (2304 + 64 * (j))
#define XB_TOP      3328
#define XB_TOPGEN   3392
#define XCD_BAR_WORDS 3456
#define XB_SPIN_CAP (1u << 18)
DEVINL unsigned xb_ld(unsigned* p)              { return __hip_atomic_load(p, __ATOMIC_RELAXED, __HIP_MEMORY_SCOPE_AGENT); }
DEVINL unsigned xb_add(unsigned* p, unsigned v) { return __hip_atomic_fetch_add(p, v, __ATOMIC_RELAXED, __HIP_MEMORY_SCOPE_AGENT); }
DEVINL unsigned xb_xcc_id() { return (unsigned)__builtin_amdgcn_s_getreg((3 << 11) | 20) & 0xFu; }
#define XB_SPIN(cond, bar) do { unsigned _sp = 0; while (cond) { __builtin_amdgcn_s_sleep(1); \
    if ((++_sp & 255u) == 0u) { if (xb_ld(&(bar)[XB_TMO])) break; if (_sp > XB_SPIN_CAP) { atomicAdd(&(bar)[XB_TMO], 1u); break; } } } } while (0)
DEVINL void xcd_barrier_complete(unsigned* bar, unsigned x, unsigned& nloc, unsigned& nx) {
    const unsigned G = gridDim.x;
    unsigned sum, cnt, mine, sp = 0u;
    for (;;) {
        sum = 0u; cnt = 0u; mine = 0u;
#pragma unroll
        for (unsigned j = 0; j < 16; ++j) { const unsigned c = xb_ld(&bar[XB_XCNT(j)]); sum += c; cnt += (c > 0u) ? 1u : 0u; mine = (j == x) ? c : mine; }
        if (sum == G) break;
        __builtin_amdgcn_s_sleep(1);
        if ((++sp & 255u) == 0u) { if (xb_ld(&bar[XB_TMO])) break; if (sp > XB_SPIN_CAP) { atomicAdd(&bar[XB_TMO], 1u); break; } }
    }
    nloc = mine > 0u ? mine : 1u; nx = cnt > 0u ? cnt : 1u;
}
DEVINL void xcd_barrier(unsigned* bar, volatile unsigned* st, int tid) {
    asm volatile("s_waitcnt vmcnt(0)" ::: "memory");
    __syncthreads();
    if (tid == 0) {
        const unsigned x = xb_xcc_id();
        __builtin_amdgcn_s_waitcnt(0);
        unsigned nloc = st[0], nx = st[1];
        if (nloc == 0u) { (void)xb_add(&bar[XB_XCNT(x)], 1u); xcd_barrier_complete(bar, x, nloc, nx); st[0] = nloc; st[1] = nx; }
        const unsigned old = xb_add(&bar[XB_XSUB(x)], 1u);
        const unsigned gen = old / nloc;
        if (old + 1u == (gen + 1u) * nloc) {
            __builtin_amdgcn_fence(__ATOMIC_RELEASE, "agent");
            asm volatile("s_waitcnt vmcnt(0)" ::: "memory");
            const unsigned og = xb_add(&bar[XB_TOP], 1u);
            const unsigned tg = og / nx;
            if (og + 1u == (tg + 1u) * nx) xb_add(&bar[XB_TOPGEN], 1u);
            else XB_SPIN(xb_ld(&bar[XB_TOPGEN]) == tg, bar);
            __builtin_amdgcn_fence(__ATOMIC_ACQUIRE, "agent");
            xb_add(&bar[XB_XGEN(x)], 1u);
            asm volatile("s_waitcnt vmcnt(0)" ::: "memory");
        } else {
            XB_SPIN(xb_ld(&bar[XB_XGEN(x)]) == gen, bar);
            __builtin_amdgcn_fence(__ATOMIC_ACQUIRE, "agent");
            asm volatile("s_waitcnt vmcnt(0)" ::: "memory");
        }
    }
    __syncthreads();
}

struct EpiProj {
    static constexpr bool PERM = true, AFTER_DRAIN = false;
    bf16_t* O; const float* ssq;
    DEVINL void operator()(const f32x4 (&acc)[2][2][4][2], const pg8::Unit& u, int wr, int wc, int fr, int fq) const {
        const int row0 = u.pm * 256 + wr * 64 + fr, col0 = u.pn * 256 + wc * 32 + 8 * fq;
#pragma unroll
        for (int ai = 0; ai < 2; ++ai)
#pragma unroll
            for (int m = 0; m < 4; ++m) {
                const int row = row0 + ai * 128 + m * 16;
                const float rs = rsqrtf(ssq[row] * (1.0f / 2048.0f) + 1e-6f);
                bf16_t* rowp = O + (size_t)row * DINP + col0;
#pragma unroll
                for (int bj = 0; bj < 2; ++bj) {
                    const f32x4 v0 = acc[ai][bj][m][0] * rs, v1 = acc[ai][bj][m][1] * rs;
                    u32x4 w; w.x = cvt_pk(v0[0], v0[1]); w.y = cvt_pk(v0[2], v0[3]); w.z = cvt_pk(v1[0], v1[1]); w.w = cvt_pk(v1[2], v1[3]);
                    *(u32x4*)(rowp + bj * 128) = w;
                }
            }
    }
};
struct EpiRes {
    static constexpr bool PERM = true, AFTER_DRAIN = false;
    const float* srcP; const float* srcS; float* xf; bf16_t* xb; float* ssq_next;
    DEVINL void operator()(const f32x4 (&acc)[2][2][4][2], const pg8::Unit& u, int wr, int wc, int fr, int fq) const {
        const int row0 = u.pm * 256 + wr * 64 + fr, col0 = u.pn * 256 + wc * 32 + 8 * fq;
#pragma unroll
        for (int ai = 0; ai < 2; ++ai) {
          if (u.half == 2 - ai) continue;
#pragma unroll
            for (int m = 0; m < 4; ++m) {
                const int row = row0 + ai * 128 + m * 16;
                const float* src = (row < MP ? srcP + (size_t)row * DM : srcS + (size_t)(row - MP) * DM) + col0;
                float* dst = xf + (size_t)row * DM + col0; bf16_t* dsb = xb + (size_t)row * DM + col0;
                float part = 0.f;
#pragma unroll
                for (int bj = 0; bj < 2; ++bj) {
                    const f32x4 y0 = *(const f32x4*)(src + bj * 128) + acc[ai][bj][m][0], y1 = *(const f32x4*)(src + bj * 128 + 4) + acc[ai][bj][m][1];
                    *(f32x4*)(dst + bj * 128) = y0; *(f32x4*)(dst + bj * 128 + 4) = y1;
                    u32x4 w; w.x = cvt_pk(y0[0], y0[1]); w.y = cvt_pk(y0[2], y0[3]); w.z = cvt_pk(y1[0], y1[1]); w.w = cvt_pk(y1[2], y1[3]);
                    if (xb) *(u32x4*)(dsb + bj * 128) = w;
                    part += y0[0] * y0[0] + y0[1] * y0[1] + y0[2] * y0[2] + y0[3] * y0[3] + y1[0] * y1[0] + y1[1] * y1[1] + y1[2] * y1[2] + y1[3] * y1[3];
                }
                part = xq_sum(part);
                if (fq == 0) atomicAdd(ssq_next + row, part);
            }
        }
    }
};
struct HalfOrder {
    pg8::StaticOrder P; int G, c;
    DEVINL void init(int G_, int c_) { P.init(MP, DM, G_, c_); G = G_; c = c_; }
    DEVINL bool next(int i, pg8::Unit& u) const {
        const long L = (long)i * G + c;
        if (L < 256) return P.next(i, u);
        if (L >= 320) return false;
        const int t = (int)(L - 256) >> 1; u.pm = 32 + (t >> 3); u.pn = t & 7; u.half = 1 + (int)((L - 256) & 1); return true;
    }
    DEVINL void a_ready(const pg8::Unit&) const {}
    DEVINL void done(const pg8::Unit&) const {}
};
DEVINL void convert_layer(const Params& p, unsigned char* lds, int l, int vb, int vG, int z, int wv) {
    LAUNDER_PTRS;
    const int tid = mk_tid(wv, z);
    float* tile = (float*)lds;
    bf16_t* WinT = (bf16_t*)(PWS + WS_WINT) + (size_t)l * DINP * DM; bf16_t* WoutT = (bf16_t*)(PWS + WS_WOUTT) + (size_t)l * DM * DM;
    constexpr int NT_IN = 32 * 106, NT_OUT = 32 * 32;
    for (int it = vb; it < NT_IN + NT_OUT; it += vG) {
        int kt, nt, ld; const float* src; const float* gs; bf16_t* dst;
        if (it < NT_IN) { nt = it % 106; kt = it / 106; ld = DIN; src = PIN(I_WIN) + (size_t)l * DM * DIN; gs = PIN(I_NORMG) + l * DM; dst = WinT; }
        else { const int r = it - NT_IN; nt = r % 32; kt = r / 32; ld = DM; src = PIN(I_WOUT) + (size_t)l * DM * DM; gs = nullptr; dst = WoutT; }
#pragma unroll
        for (int ps = 0; ps < 2; ++ps) {
            const int row = (tid >> 4) + ps * 32, c4 = (tid & 15) * 4;
            const float4 v = *(const float4*)(src + (size_t)(kt * 64 + row) * ld + nt * 64 + c4);
            const float s = gs ? gs[kt * 64 + row] : 1.f;
            float* tp = tile + row * 65 + c4; tp[0] = v.x * s; tp[1] = v.y * s; tp[2] = v.z * s; tp[3] = v.w * s;
        }
        __syncthreads();
        { const int n = tid >> 3, kg = (tid & 7) * 8; const float* tp = tile + kg * 65 + n;
          u32x4 w; w.x = cvt_pk(tp[0], tp[65]); w.y = cvt_pk(tp[130], tp[195]); w.z = cvt_pk(tp[260], tp[325]); w.w = cvt_pk(tp[390], tp[455]);
          *(u32x4*)(dst + (size_t)(nt * 64 + n) * DM + kt * 64 + kg) = w; }
        __syncthreads();
    }
    for (int i = vb * 512 + tid; i < 128 * 256; i += vG * 512) *(u32x4*)(WinT + (size_t)DIN * DM + (size_t)i * 8) = (u32x4){0u, 0u, 0u, 0u};
}

DEVINL void phase0(const Params& p, unsigned char* lds, int z, int wv) {
    LAUNDER_PTRS;
    const int tid = mk_tid(wv, z), G = gridDim.x, bid = (int)(blockIdx.x + z), lane = tid & 63;
    convert_layer(p, lds, 0, bid, G, z, wv);
    const int gtid = bid * 512 + tid, gthreads = G * 512;
    bf16_t* xb = (bf16_t*)(PWS + WS_XB); float* ssq = (float*)(PWS + WS_SSQ);
    for (int m = bid * 8 + (tid >> 6); m < MTOT; m += G * 8) {
        const float* src = m < MP ? PIN(I_XP) + (size_t)m * DM : PIN(I_XS) + (size_t)(m - MP) * DM;
        float ss = 0.f;
#pragma unroll
        for (int i = 0; i < 8; ++i) { const f32x4 v = *(const f32x4*)(src + i * 256 + lane * 4); ss += v[0] * v[0] + v[1] * v[1] + v[2] * v[2] + v[3] * v[3]; st4bf(xb + (size_t)m * DM + i * 256 + lane * 4, v); }
        ss = wave_sum(ss);
        if (lane == 0) ssq[m] = ss;
    }
    for (int i = gtid; i < 4 * MTOT; i += gthreads) ssq[MTOT + i] = 0.f;
    {
        bf16_t* prevb = (bf16_t*)(PWS + WS_PREV);
        for (int i = gtid; i < NL * 128 * SHW; i += gthreads) prevb[i] = f2bf(PIN(I_SSHIFT)[i]);
        for (int i = gtid; i < SHW; i += gthreads) ((bf16_t*)(PWS + WS_ZROW))[i] = 0;
    }
    bf16_t* wupT = (bf16_t*)(PWS + WS_WUPT); bf16_t* aupT = (bf16_t*)(PWS + WS_AUPT); bf16_t* poolwT = (bf16_t*)(PWS + WS_POOLWT);
    for (int i = gtid; i < NL * 1024 * 64; i += gthreads) { const int l = i >> 16, c = (i >> 6) & 1023, j = i & 63; const size_t s = ((size_t)l * 64 + j) * 1024 + c; wupT[i] = f2bf(PIN(I_WUP)[s]); aupT[i] = f2bf(PIN(I_AUP)[s]); }
    for (int i = gtid; i < NL * 4 * 128 * 128; i += gthreads) { const int lg = i >> 14, d = (i >> 7) & 127, c = i & 127; poolwT[i] = f2bf(PIN(I_POOLW)[((size_t)lg * 128 + c) * 128 + d]); }
}

DEVINL void item_prep(const Params& p, unsigned char* lds, int tt, int l, int z, int wv) {
    LAUNDER_PTRS;
    const int tid = mk_tid(wv, z), lane = tid & 63, w = tid >> 6, fr = lane & 15, fq = lane >> 4;
    const int m0 = tt * 16;
    const bf16_t* proj = (const bf16_t*)(PWS + WS_PROJ);
    const float* mu = PIN(I_MU) + l * SHW;
    constexpr int RS = 3208;
    bf16_t* L = (bf16_t*)lds; bf16_t* Aw = L + 18 * RS; bf16_t* Aa = Aw + 16 * 72;
    {
        const bf16_t* srcA; const bf16_t* srcB;
        if (m0 < MP) { srcA = (m0 & 2047) ? proj + (size_t)(m0 - 1) * DINP : (const bf16_t*)(PWS + WS_ZROW); srcB = proj + (size_t)(m0 + 7) * DINP; }
        else { const int b0 = (m0 - MP) >> 3; srcA = (const bf16_t*)(PWS + WS_PREV) + ((size_t)l * 128 + b0) * SHW; srcB = srcA + SHW; }
        u32x4 st[15];
#pragma unroll
        for (int k = 0; k < 15; ++k) {
            const int idx = tid + k * 512, r = idx / 400, pc = idx % 400;
            const bf16_t* src = (r == 0) ? srcA : (r == 9) ? srcB : proj + (size_t)(m0 + (r < 9 ? r - 1 : r - 2)) * DINP;
            st[k] = (u32x4){0u, 0u, 0u, 0u};
            if (idx < 18 * 400) st[k] = *(const u32x4*)(src + pc * 8);
        }
#pragma unroll
        for (int k = 0; k < 15; ++k) { const int idx = tid + k * 512, r = idx / 400, pc = idx % 400; if (idx < 18 * 400) *(u32x4*)(L + r * RS + pc * 8) = st[k]; }
    }
    __syncthreads();
    for (int e = tid; e < 2048; e += 512) {
        const int tok = e >> 7, j = e & 127, c = 3072 + j, lr = tok + 1 + (tok >> 3);
        const float cur = bf2f(L[lr * RS + c]), prv = bf2f(L[(lr - 1) * RS + c]);
        const float x = cur + (prv - cur) * mu[c];
        if (j < 64) Aw[tok * 72 + j] = f2bf(1.f - 2.f * __builtin_amdgcn_rcpf(1.f + __expf(2.f * x))); else Aa[tok * 72 + (j - 64)] = f2bf(x);
    }
    __syncthreads();
    bf16x8 tw[2], ta[2];
#pragma unroll
    for (int ks = 0; ks < 2; ++ks) { tw[ks] = *(const bf16x8*)(Aw + fr * 72 + ks * 32 + fq * 8); ta[ks] = *(const bf16x8*)(Aa + fr * 72 + ks * 32 + fq * 8); }
    const int m = m0 + fr;
    const bf16_t* prow = L + (fr + 1 + (fr >> 3)) * RS;
    const bf16_t* pprev = prow - RS;
    const bf16_t* wupT = (const bf16_t*)(PWS + WS_WUPT) + (size_t)l * 1024 * 64; const bf16_t* aupT = (const bf16_t*)(PWS + WS_AUPT) + (size_t)l * 1024 * 64;
    const float* w0 = PIN(I_W0) + l * 1024; const float* a0 = PIN(I_A0) + l * 1024; const float* k_k = PIN(I_KK) + l * 1024; const float* k_a = PIN(I_KA) + l * 1024; const float* r_k = PIN(I_RK) + l * 1024;
    bf16_t* sc = (bf16_t*)(PWS + WS_SCAN); float* rkb = (float*)(PWS + WS_RKB);
#pragma unroll 2
    for (int hh = 0; hh < 2 * REP_PR2; ++hh) {
        const int h = w * 2 + (hh & 1);
        f32x4 aw[4], aa[4];
#pragma unroll
        for (int nt = 0; nt < 4; ++nt) {
            const int crow = h * 64 + (fr >> 2) * 16 + nt * 4 + (fr & 3);
            aw[nt] = (f32x4){0.f, 0.f, 0.f, 0.f}; aa[nt] = (f32x4){0.f, 0.f, 0.f, 0.f};
#pragma unroll
            for (int ks = 0; ks < 2; ++ks) {
                const bf16x8 fw = *(const bf16x8*)(wupT + (size_t)crow * 64 + ks * 32 + fq * 8), fa = *(const bf16x8*)(aupT + (size_t)crow * 64 + ks * 32 + fq * 8);
                aw[nt] = mfma16(fw, tw[ks], aw[nt]); aa[nt] = mfma16(fa, ta[ks], aa[nt]);
            }
        }
        u32x4 Rc[2], Kc[2], Vc[2], Rp[2], Kp[2], Vp[2];
        { const int cb = h * 64 + fq * 16;
#pragma unroll
          for (int q = 0; q < 2; ++q) { Rc[q] = *(const u32x4*)(prow + cb + q * 8); Kc[q] = *(const u32x4*)(prow + 1024 + cb + q * 8); Vc[q] = *(const u32x4*)(prow + 2048 + cb + q * 8);
              Rp[q] = *(const u32x4*)(pprev + cb + q * 8); Kp[q] = *(const u32x4*)(pprev + 1024 + cb + q * 8); Vp[q] = *(const u32x4*)(pprev + 2048 + cb + q * 8); } }
#define UNPK(P, nt) ((f32x4){__uint_as_float(P[(nt) >> 1][((nt) & 1) * 2] << 16), __uint_as_float(P[(nt) >> 1][((nt) & 1) * 2] & 0xFFFF0000u), __uint_as_float(P[(nt) >> 1][((nt) & 1) * 2 + 1] << 16), __uint_as_float(P[(nt) >> 1][((nt) & 1) * 2 + 1] & 0xFFFF0000u)})
        bf16_t* rec = sc + ((size_t)m * 16 + h) * REC + fq * 16;
        f32x4 kkq[4], aq[4]; float ss = 0.f, rk = 0.f;
        u32x2 pd[4], pkp[4], pr_[4], pv_[4];
#pragma unroll
        for (int nt = 0; nt < 4; ++nt) {
            const int c = h * 64 + fq * 16 + nt * 4;
            const f32x4 cr = UNPK(Rc, nt), ck = UNPK(Kc, nt), cv = UNPK(Vc, nt), pr = UNPK(Rp, nt), pk = UNPK(Kp, nt), pv = UNPK(Vp, nt);
            const f32x4 muk = *(const f32x4*)(mu + 1024 + c), kkw = *(const f32x4*)(k_k + c);
            const f32x4 r = cr + (pr - cr) * *(const f32x4*)(mu + c), k = ck + (pk - ck) * muk, v = cv + (pv - cv) * *(const f32x4*)(mu + 2048 + c);
            const f32x4 wp = aw[nt] + *(const f32x4*)(w0 + c), ap = aa[nt] + *(const f32x4*)(a0 + c);
            f32x4 dv, av;
#pragma unroll
            for (int e = 0; e < 4; ++e) {
                dv[e] = -0.60653066f * __builtin_amdgcn_rcpf(1.f + __expf(-wp[e]));
                av[e] = __builtin_amdgcn_rcpf(1.f + __expf(-ap[e]));
            }
            const f32x4 kk = k * kkw;
            ss += kk[0] * kk[0] + kk[1] * kk[1] + kk[2] * kk[2] + kk[3] * kk[3];
            const f32x4 kp = k * (1.f + (av - 1.f) * *(const f32x4*)(k_a + c));
            const f32x4 rkv = r * kp * *(const f32x4*)(r_k + c);
            rk += rkv[0] + rkv[1] + rkv[2] + rkv[3];
            pd[nt] = (u32x2){cvt_pk(dv[0], dv[1]), cvt_pk(dv[2], dv[3])}; pkp[nt] = (u32x2){cvt_pk(kp[0], kp[1]), cvt_pk(kp[2], kp[3])};
            pr_[nt] = (u32x2){cvt_pk(r[0], r[1]), cvt_pk(r[2], r[3])}; pv_[nt] = (u32x2){cvt_pk(v[0], v[1]), cvt_pk(v[2], v[3])};
            kkq[nt] = kk; aq[nt] = av;
        }
        ss = xq_sum(ss); rk = xq_sum(rk);
        const float inv = rsqrtf(fmaxf(ss, 1e-12f));
        u32x2 pn[4], pb_[4];
#pragma unroll
        for (int nt = 0; nt < 4; ++nt) {
            const f32x4 kn = kkq[nt] * inv, bb = kn * aq[nt];
            pn[nt] = (u32x2){cvt_pk(-kn[0], -kn[1]), cvt_pk(-kn[2], -kn[3])}; pb_[nt] = (u32x2){cvt_pk(bb[0], bb[1]), cvt_pk(bb[2], bb[3])};
        }
#define ST16(vec, P) do { *(u32x4*)(rec + (vec) * 64) = (u32x4){P[0].x, P[0].y, P[1].x, P[1].y}; *(u32x4*)(rec + (vec) * 64 + 8) = (u32x4){P[2].x, P[2].y, P[3].x, P[3].y}; } while (0)
        ST16(0, pd); ST16(1, pn); ST16(2, pb_); ST16(3, pkp); ST16(4, pr_); ST16(5, pv_);
#undef ST16
        if (fq == 0) rkb[((size_t)m * 16 + h) * 4] = rk;
    }
#undef UNPK
    __syncthreads();
}

DEVINL void item_pool(const Params& p, unsigned char* lds, int pt, int g, int l, int z, int wv) {
    LAUNDER_PTRS;
    const int tid = mk_tid(wv, z), lane = tid & 63, w = tid >> 6, fr = lane & 15, fq = lane >> 4;
    const int m0 = pt * 64, win = 2 << g; const bool smp = pt >= 128;
    const bf16_t* proj = (const bf16_t*)(PWS + WS_PROJ); bf16_t* cat = (bf16_t*)(PWS + WS_CAT);
    const float* stp = PIN(I_SPOOL) + (size_t)l * 128 * 15 * 512;
    bf16_t* Ap = (bf16_t*)lds;
    float* U = (float*)(lds + 64 * 136 * 2);
    if (!smp) {
        const int t0 = m0 & 2047;
        u32x2 raw[5];
#pragma unroll
        for (int k = 0; k < 5; ++k) { const int idx = tid + k * 512, r = idx >> 5, q = idx & 31; raw[k] = (u32x2){0u, 0u};
            if (idx < 79 * 32 && t0 - 15 + r >= 0) raw[k] = *(const u32x2*)(proj + (size_t)(m0 - 15 + r) * DINP + C_UB + g * 128 + q * 4); }
#pragma unroll
        for (int k = 0; k < 5; ++k) { const int idx = tid + k * 512, r = idx >> 5, q = idx & 31;
            if (idx < 79 * 32) *(f32x4*)(U + r * 132 + q * 4) = (f32x4){__uint_as_float(raw[k].x << 16), __uint_as_float(raw[k].x & 0xFFFF0000u), __uint_as_float(raw[k].y << 16), __uint_as_float(raw[k].y & 0xFFFF0000u)}; }
    } else {
        const int b0 = (m0 - MP) >> 3;
#pragma unroll
        for (int k0 = 0; k0 < 12; k0 += 6) {
            f32x4 vv[6];
#pragma unroll
            for (int k = 0; k < 6; ++k) { const int idx = tid + (k0 + k) * 512, r = idx >> 5, q = idx & 31, bl = r / 23, rr = r % 23; vv[k] = (f32x4){0.f, 0.f, 0.f, 0.f};
                if (idx < 184 * 32) { if (rr < 15) vv[k] = *(const f32x4*)(stp + ((size_t)(b0 + bl) * 15 + rr) * 512 + g * 128 + q * 4); else vv[k] = ld4bf(proj + (size_t)(m0 + bl * 8 + rr - 15) * DINP + C_UB + g * 128 + q * 4); } }
#pragma unroll
            for (int k = 0; k < 6; ++k) { const int idx = tid + (k0 + k) * 512, r = idx >> 5, q = idx & 31; if (idx < 184 * 32) *(f32x4*)(U + r * 132 + q * 4) = vv[k]; }
        }
    }
    __syncthreads();
    {
        const int col = tid & 127, tb = (tid >> 7) * 16;
#pragma unroll
        for (int hf = 0; hf < 2; ++hf) {
            const int tok0 = tb + hf * 8;
            const int rr0 = smp ? ((tok0 >> 3) * 23 + 15) : (15 + tok0);
            const float* up = U + rr0 * 132 + col;
            float sum = 0.f;
#pragma unroll
            for (int d = 0; d < 16; ++d) { const float x = up[-(d < win ? d : 0) * 132]; sum += (d < win) ? x : 0.f; }
#pragma unroll
            for (int i = 0; i < 8; ++i) {
                const int tok = tok0 + i;
                const float u0 = up[i * 132];
                if (i > 0) sum += u0 - up[(i - win) * 132];
                const float cnt = smp ? (float)win : (float)min(((m0 + tok) & 2047) + 1, win);
                Ap[tok * 136 + col] = f2bf(sum * __builtin_amdgcn_rcpf(cnt) - u0);
            }
        }
    }
    __syncthreads();
    const bf16_t* pw = (const bf16_t*)(PWS + WS_POOLWT) + (size_t)(l * 4 + g) * 128 * 128;
    bf16x8 fa[4];
#pragma unroll
    for (int ks = 0; ks < 4; ++ks) fa[ks] = *(const bf16x8*)(pw + (size_t)(w * 16 + fr) * 128 + ks * 32 + fq * 8);
    const int d0 = g * 128 + w * 16 + fq * 4;
    const f32x4 scl = *(const f32x4*)(PIN(I_POOLS) + l * 512 + d0);
#pragma unroll
    for (int mt = 0; mt < 4; ++mt) {
        f32x4 acc = {0.f, 0.f, 0.f, 0.f};
#pragma unroll
        for (int ks = 0; ks < 4; ++ks) acc = mfma16(fa[ks], *(const bf16x8*)(Ap + (mt * 16 + fr) * 136 + ks * 32 + fq * 8), acc);
        const int m = m0 + mt * 16 + fr;
        const f32x4 gb = ld4bf(proj + (size_t)m * DINP + C_GB + d0);
        f32x4 o;
#pragma unroll
        for (int e = 0; e < 4; ++e) o[e] = acc[e] * scl[e] * siluf(gb[e]);
        st4bf(cat + (size_t)m * DM + 1024 + d0, o);
    }
    __syncthreads();
}

DEVINL void item_chunk(const Params& p, unsigned char* lds, int ck, int g, int l, int z, int wv) {
    LAUNDER_PTRS;
    const int tid = mk_tid(wv, z), lane = tid & 63, w = tid >> 6, fr = lane & 15, fq = lane >> 4;
    const int m0 = ck * 128; const bool smp = ck >= 64;
    const bf16_t* proj = (const bf16_t*)(PWS + WS_PROJ); bf16_t* cat = (bf16_t*)(PWS + WS_CAT);
    bf16_t* vnT = (bf16_t*)lds;
    bf16_t* Aws = vnT + 128 * 136;
    float* stats = (float*)(Aws + 128 * 136);
    const int tok = tid >> 2, part = tid & 3, m = m0 + tok;
    {
        const bf16_t* vp = proj + (size_t)m * DINP + C_VC + part * 128;
        float s = 0.f, q = 0.f;
#pragma unroll
        for (int i = 0; i < 32; ++i) { const f32x4 v = ld4bf(vp + i * 4); s += v[0] + v[1] + v[2] + v[3]; q += v[0] * v[0] + v[1] * v[1] + v[2] * v[2] + v[3] * v[3]; }
        s += __shfl_xor(s, 1); s += __shfl_xor(s, 2); q += __shfl_xor(q, 1); q += __shfl_xor(q, 2);
        const float mean = s * (1.f / 512.f), var = fmaxf(q * (1.f / 512.f) - mean * mean, 0.f);
        if (part == 0) { stats[tok * 2] = mean; stats[tok * 2 + 1] = rsqrtf(var + 1e-5f); }
    }
    __syncthreads();
    {
        const float mean = stats[tok * 2], rstd = stats[tok * 2 + 1];
        const float* lng = PIN(I_GLNG) + l * 512 + g * 128 + part * 32;
        const bf16_t* vp = proj + (size_t)m * DINP + C_VC + g * 128 + part * 32;
#pragma unroll
        for (int i = 0; i < 8; ++i) {
            const f32x4 v = ld4bf(vp + i * 4); const f32x4 gg = *(const f32x4*)(lng + i * 4);
            f32x4 vn;
#pragma unroll
            for (int e = 0; e < 4; ++e) { vn[e] = (v[e] - mean) * rstd * gg[e]; vnT[(part * 32 + i * 4 + e) * 136 + tok] = f2bf(vn[e]); }
            if (smp) *(f32x4*)(POUT + O_SV + ((size_t)l * 1024 + (m - MP)) * 512 + g * 128 + part * 32 + i * 4) = vn;
        }
        const float* wsg = PIN(I_GWS) + (size_t)(l * 4 + g) * 128 * 128;
        const int t = tok;
#pragma unroll
        for (int i = 0; i < 8; ++i) {
            const int s0 = part * 32 + i * 4;
            f32x4 a;
            if (!smp) { a = *(const f32x4*)(wsg + (size_t)t * 128 + s0);
#pragma unroll
                for (int e = 0; e < 4; ++e) a[e] = (s0 + e <= t) ? a[e] : 0.f; }
            else {
#pragma unroll
                for (int e = 0; e < 4; ++e) { const int s = s0 + e; a[e] = ((s >> 3) == (t >> 3) && (s & 7) <= (t & 7)) ? wsg[(t & 7) * 128 + (s & 7)] : 0.f; } }
            st4bf(Aws + t * 136 + s0, a);
        }
    }
    __syncthreads();
    bf16x8 fa[4];
#pragma unroll
    for (int ks = 0; ks < 4; ++ks) fa[ks] = *(const bf16x8*)(vnT + (w * 16 + fr) * 136 + ks * 32 + fq * 8);
    const int c0 = g * 128 + w * 16 + fq * 4;
    const float* gbias = PIN(I_GB) + (l * 4 + g) * 128;
    u32x2 ucr[8], gcr[8];
#pragma unroll
    for (int tt = 0; tt < 8; ++tt) { const size_t ro = (size_t)(m0 + tt * 16 + fr) * DINP + c0; ucr[tt] = *(const u32x2*)(proj + ro + C_UC); gcr[tt] = *(const u32x2*)(proj + ro + C_GC); }
#pragma unroll
    for (int tt = 0; tt < 8; ++tt) {
        f32x4 acc = {0.f, 0.f, 0.f, 0.f};
#pragma unroll
        for (int ks = 0; ks < 4; ++ks) {
            const bool need = smp ? (ks == (tt >> 1)) : (ks <= (tt >> 1));
            if (need) acc = mfma16(fa[ks], *(const bf16x8*)(Aws + (tt * 16 + fr) * 136 + ks * 32 + fq * 8), acc);
        }
        const int t = tt * 16 + fr, mm = m0 + t;
        const float bias = gbias[smp ? (t & 7) : t];
        f32x4 uc, gc;
        uc[0] = __uint_as_float(ucr[tt].x << 16); uc[1] = __uint_as_float(ucr[tt].x & 0xFFFF0000u); uc[2] = __uint_as_float(ucr[tt].y << 16); uc[3] = __uint_as_float(ucr[tt].y & 0xFFFF0000u);
        gc[0] = __uint_as_float(gcr[tt].x << 16); gc[1] = __uint_as_float(gcr[tt].x & 0xFFFF0000u); gc[2] = __uint_as_float(gcr[tt].y << 16); gc[3] = __uint_as_float(gcr[tt].y & 0xFFFF0000u);
        f32x4 o;
#pragma unroll
        for (int e = 0; e < 4; ++e) o[e] = uc[e] * (acc[e] + bias) * siluf(gc[e]);
        st4bf(cat + (size_t)mm * DM + 1536 + c0, o);
    }
    __syncthreads();
}

DEVINL void phase2a(const Params& p, unsigned char* lds, int l, int z, int wv) {
    LAUNDER_PTRS;
    const int G = gridDim.x, bid = (int)(blockIdx.x + z), tid = mk_tid(wv, z);
    for (int it = bid; it < 288 + 576 + 576; it += G) {
        if (it < 288) { for (int rep = 0; rep < REP_CH; ++rep) item_chunk(p, lds, it >> 2, it & 3, l, z, wv); }
        else if (it < 864) { const int j = it - 288; for (int rep = 0; rep < REP_PL; ++rep) item_pool(p, lds, j >> 2, j & 3, l, z, wv); }
        else { for (int rep = 0; rep < REP_PR; ++rep) item_prep(p, lds, it - 864, l, z, wv); }
    }
    const bf16_t* proj = (const bf16_t*)(PWS + WS_PROJ);
    const int gtid = bid * 512 + tid, gthreads = G * 512;
    for (int i = gtid; i < 132 * (SHW / 4); i += gthreads) {
        const int b = i / (SHW / 4), c = (i % (SHW / 4)) * 4;
        if (b < 4) *(f32x4*)(POUT + O_PSHIFT + ((size_t)l * 4 + b) * SHW + c) = ld4bf(proj + (size_t)(b * 2048 + 2047) * DINP + c);
        else *(f32x4*)(POUT + O_SSHIFT + ((size_t)l * 128 + (b - 4)) * SHW + c) = ld4bf(proj + (size_t)(MP + (b - 4) * 8 + 7) * DINP + c);
    }
    for (int i = gtid; i < 132 * 15 * 128; i += gthreads) {
        const int b = i / (15 * 128), r = (i / 128) % 15, c = (i % 128) * 4;
        if (b < 4) *(f32x4*)(POUT + O_PPOOL + (((size_t)l * 4 + b) * 15 + r) * 512 + c) = ld4bf(proj + (size_t)(b * 2048 + 2033 + r) * DINP + C_UB + c);
        else { const int bb = b - 4;
            *(f32x4*)(POUT + O_SPOOL + (((size_t)l * 128 + bb) * 15 + r) * 512 + c) = (r < 7) ? *(const f32x4*)(PIN(I_SPOOL) + (((size_t)l * 128 + bb) * 15 + 8 + r) * 512 + c) : ld4bf(proj + (size_t)(MP + bb * 8 + (r - 7)) * DINP + C_UB + c); }
    }
}
typedef float f32x2 __attribute__((ext_vector_type(2)));
#define LDS_BARRIER() do { asm volatile("s_waitcnt lgkmcnt(0)" ::: "memory"); __builtin_amdgcn_s_barrier(); asm volatile("" ::: "memory"); } while (0)
struct ScanOps { f32x4 w, b, k, r; float v; };
DEVINL float dot4(f32x2 s01, f32x2 s23, f32x4 x) { f32x2 t = s01 * (f32x2){x[0], x[1]}; t = s23 * (f32x2){x[2], x[3]} + t; return t[0] + t[1]; }
DEVINL void dual_allreduce16(float& a, float& b) {
    a = dpp_add<0x128>(a); b = dpp_add<0x128>(b); a = dpp_add<0x124>(a); b = dpp_add<0x124>(b);
    a = dpp_add<0x122>(a); b = dpp_add<0x122>(b); a = dpp_add<0x121>(a); b = dpp_add<0x121>(b);
}
#define SCAN_LOAD(o, sp, irow) do { (o).w = *(const f32x4*)((sp) + kq * 4); (o).b = *(const f32x4*)((sp) + 128 + kq * 4); (o).k = *(const f32x4*)((sp) + 192 + kq * 4); (o).r = *(const f32x4*)((sp) + 256 + kq * 4); (o).v = (sp)[320 + (irow)]; } while (0)
#define SCAN_UPD(S01, S23, o, sa) do { \
        S01 = S01 * (f32x2){(o).w[0], (o).w[1]} + (f32x2){(o).b[0], (o).b[1]} * (sa) + (f32x2){(o).k[0], (o).k[1]} * (o).v; \
        S23 = S23 * (f32x2){(o).w[2], (o).w[3]} + (f32x2){(o).b[2], (o).b[3]} * (sa) + (f32x2){(o).k[2], (o).k[3]} * (o).v; } while (0)

DEVINL void piece_to_lds(float* dst, u32x4 w, bool is_decay) {
    f32x4 lo, hi;
    lo[0] = __uint_as_float(w.x << 16); lo[1] = __uint_as_float(w.x & 0xFFFF0000u); lo[2] = __uint_as_float(w.y << 16); lo[3] = __uint_as_float(w.y & 0xFFFF0000u);
    hi[0] = __uint_as_float(w.z << 16); hi[1] = __uint_as_float(w.z & 0xFFFF0000u); hi[2] = __uint_as_float(w.w << 16); hi[3] = __uint_as_float(w.w & 0xFFFF0000u);
    if (is_decay) {
#pragma unroll
        for (int e = 0; e < 4; ++e) { lo[e] = __expf(lo[e]); hi[e] = __expf(hi[e]); }
    }
    *(f32x4*)dst = lo; *(f32x4*)(dst + 4) = hi;
}

constexpr int TC = 16, NCH = 2048 / TC;
constexpr int SLOT = TC * 384 + 64;
struct ScanOps2 { f32x4 w, g, b, k, r; float v; f32x2 bk; };
#define SCAN_LOAD2(o, cb, s, irow) do { const float* sp_ = (cb) + (s) * 384; (o).w = *(const f32x4*)(sp_ + kq * 4); (o).g = *(const f32x4*)(sp_ + 64 + kq * 4); (o).b = *(const f32x4*)(sp_ + 128 + kq * 4); \
        (o).k = *(const f32x4*)(sp_ + 192 + kq * 4); (o).r = *(const f32x4*)(sp_ + 256 + kq * 4); (o).v = sp_[320 + (irow)]; (o).bk = *(const f32x2*)((cb) + TC * 384 + (s) * 2); } while (0)
DEVINL void scan_prompt(const Params& p, unsigned char* lds, int it, int l, int z, int wv) {
    LAUNDER_PTRS;
    const int tid = mk_tid(wv, z), w = tid >> 6, lane = tid & 63;
    const int v = (it & 7) * 32 + (it >> 3), bh = v >> 2, q4 = v & 3, b = bh >> 4, h = bh & 15, hc = h * 64;
    float* buf = (float*)lds;
    float* ypb = buf + 2 * TC * 384;
    const bf16_t* sc = (const bf16_t*)(PWS + WS_SCAN); float* ybuf = (float*)(PWS + WS_Y);
    const size_t rowbase = (size_t)b * 2048;
    if (w >= 4) {
        const int lt = tid - 256;
        int goff[3], loff[3]; bool dec[3];
#pragma unroll
        for (int q = 0; q < 3; ++q) { const int pi = lt + 256 * q, t = pi / 48, r = pi % 48; goff[q] = t * 16 * REC + r * 8; loff[q] = t * 384 + (r >> 3) * 64 + (r & 7) * 8; dec[q] = (r >> 3) == 0; }
        const bf16_t* gb = sc + (rowbase * 16 + h) * REC;
        u32x4 pa[3], pb[3];
#define LD_ISSUE(set, c) do { _Pragma("unroll") for (int q = 0; q < 3; ++q) set[q] = *(const u32x4*)(gb + (size_t)(c) * (TC * 16 * REC) + goff[q]); } while (0)
#define LD_WRITE(set, slot) do { _Pragma("unroll") for (int q = 0; q < 3; ++q) piece_to_lds(buf + (slot) * (TC * 384) + loff[q], set[q], dec[q]); } while (0)
#define Y_FLUSH(c) do { const float* yp_ = ypb + ((c) & 1) * (TC * 256) + lt * 16; const f32x4 a_ = *(const f32x4*)yp_, b_ = *(const f32x4*)(yp_ + 4), c_ = *(const f32x4*)(yp_ + 8), d_ = *(const f32x4*)(yp_ + 12); \
        const f32x4 s_ = (a_ + b_) + (c_ + d_); ybuf[(rowbase + (size_t)(c) * TC + (lt >> 4)) * 1024 + hc + q4 * 16 + (lt & 15)] = (s_[0] + s_[1]) + (s_[2] + s_[3]); } while (0)
        LD_ISSUE(pa, 0); LD_WRITE(pa, 0); LD_ISSUE(pb, 1); LD_ISSUE(pa, 2);
        LDS_BARRIER();
        for (int c = 0; c < NCH; c += 2) {
            if (c > 0) Y_FLUSH(c - 1);
            LD_WRITE(pb, 1); if (c + 3 < NCH) LD_ISSUE(pb, c + 3);
            LDS_BARRIER();
            Y_FLUSH(c);
            if (c + 2 < NCH) LD_WRITE(pa, 0);
            if (c + 4 < NCH) LD_ISSUE(pa, c + 4);
            LDS_BARRIER();
        }
        Y_FLUSH(NCH - 1);
#undef LD_ISSUE
#undef LD_WRITE
#undef Y_FLUSH
    } else {
        const int il = lane >> 4, kq = lane & 15, i = q4 * 16 + w * 4 + il;
        f32x2 S01 = {0.f, 0.f}, S23 = {0.f, 0.f};
        LDS_BARRIER();
        for (int c = 0; c < NCH; ++c) {
            const float* cb = buf + (c & 1) * (TC * 384);
            float* yp = ypb + (c & 1) * (TC * 256) + w * 64 + lane;
            ScanOps cur; SCAN_LOAD(cur, cb, i); f32x4 nk = *(const f32x4*)(cb + 64 + kq * 4);
#pragma unroll
            for (int s = 0; s < TC; ++s) {
                ScanOps nxt; f32x4 nkn;
                if (s + 1 < TC) { SCAN_LOAD(nxt, cb + (s + 1) * 384, i); nkn = *(const f32x4*)(cb + (s + 1) * 384 + 64 + kq * 4); }
                const float sa = allreduce16(dot4(S01, S23, nk));
                SCAN_UPD(S01, S23, cur, sa);
                yp[s * 256] = dot4(S01, S23, cur.r);
                if (s + 1 < TC) { cur = nxt; nk = nkn; }
            }
            LDS_BARRIER();
        }
        *(f32x4*)(POUT + O_PWKV + ((((size_t)l * 4 + b) * 16 + h) * 64 + i) * 64 + kq * 4) = (f32x4){S01[0], S01[1], S23[0], S23[1]};
    }
}

DEVINL void scan_sample_all(const Params& p, unsigned char* lds, int l, int z, int wv) {
    LAUNDER_PTRS;
    const int tid = mk_tid(wv, z), w = tid >> 6, lane = tid & 63, il = lane >> 4, kq = lane & 15;
    const int G = gridDim.x;
    float* buf = (float*)lds;
    const bf16_t* sc = (const bf16_t*)(PWS + WS_SCAN); float* ybuf = (float*)(PWS + WS_Y);
    const int ia = w * 4 + il, ib = ia + 32;
    const bool ldr = tid < 384;
    const int t_0 = tid / 48, r_0 = tid % 48;
    int it = (int)(blockIdx.x + z);
    u32x4 in0 = {0u, 0u, 0u, 0u}; f32x4 Sa, Sb;
#define SMP_PRELOAD(itx) do { const int b_ = (itx) >> 4, h_ = (itx) & 15; \
        if (ldr) in0 = *(const u32x4*)(sc + (((size_t)MP + b_ * 8 + t_0) * 16 + h_) * REC + r_0 * 8); \
        const size_t sb_ = ((size_t)l * 2048 + (itx)) * 4096; Sa = *(const f32x4*)(PIN(I_SWKV) + sb_ + ia * 64 + kq * 4); Sb = *(const f32x4*)(PIN(I_SWKV) + sb_ + ib * 64 + kq * 4); } while (0)
    if (it < 2048) SMP_PRELOAD(it);
    while (it < 2048) {
        if (ldr) piece_to_lds(buf + t_0 * 384 + (r_0 >> 3) * 64 + (r_0 & 7) * 8, in0, (r_0 >> 3) == 0);
        f32x2 A01 = {Sa[0], Sa[1]}, A23 = {Sa[2], Sa[3]}, B01 = {Sb[0], Sb[1]}, B23 = {Sb[2], Sb[3]};
        LDS_BARRIER();
        const int nxt = it + G;
        if (nxt < 2048) SMP_PRELOAD(nxt);
        const int b = it >> 4, hc = (it & 15) * 64; const size_t row0 = (size_t)MP + b * 8;
        float ka = 0.f, kb = 0.f;
#pragma unroll
        for (int s = 0; s < 8; ++s) {
            const float* sp = buf + s * 384;
            const f32x4 nk = *(const f32x4*)(sp + 64 + kq * 4);
            ScanOps oa; SCAN_LOAD(oa, sp, ia); const float vb = sp[320 + ib];
            float sa = dot4(A01, A23, nk), sb = dot4(B01, B23, nk); dual_allreduce16(sa, sb);
            SCAN_UPD(A01, A23, oa, sa); oa.v = vb; SCAN_UPD(B01, B23, oa, sb);
            float ya = dot4(A01, A23, oa.r), yb = dot4(B01, B23, oa.r); dual_allreduce16(ya, yb);
            ka = (kq == s) ? ya : ka; kb = (kq == s) ? yb : kb;
        }
        if (kq < 8) { ybuf[(row0 + kq) * 1024 + hc + ia] = ka; ybuf[(row0 + kq) * 1024 + hc + ib] = kb; }
        const size_t sbase = ((size_t)l * 2048 + it) * 4096;
        *(f32x4*)(POUT + O_SWKV + sbase + ia * 64 + kq * 4) = (f32x4){A01[0], A01[1], A23[0], A23[1]};
        *(f32x4*)(POUT + O_SWKV + sbase + ib * 64 + kq * 4) = (f32x4){B01[0], B01[1], B23[0], B23[1]};
        LDS_BARRIER();
        it = nxt;
    }
#undef SMP_PRELOAD
}

DEVINL void phase2b(const Params& p, unsigned char* lds, int l, int z, int wv) {
    const int G = gridDim.x, bid = (int)(blockIdx.x + z);
    for (int rep = 0; rep < REP_PS; ++rep) for (int it = bid; it < 256; it += G) scan_prompt(p, lds, it, l, z, wv);
    for (int rep = 0; rep < REP_SP; ++rep) scan_sample_all(p, lds, l, z, wv);
}

DEVINL void phase2c(const Params& p, int l, int z, int wv) {
    LAUNDER_PTRS;
    const int gtid = (int)(blockIdx.x + z) * 512 + mk_tid(wv, z), gthreads = gridDim.x * 512;
    const float* ybuf = (const float*)(PWS + WS_Y); const bf16_t* scr = (const bf16_t*)(PWS + WS_SCAN); const float* rkb = (const float*)(PWS + WS_RKB);
    const bf16_t* proj = (const bf16_t*)(PWS + WS_PROJ); bf16_t* cat = (bf16_t*)(PWS + WS_CAT);
    const float* lg = PIN(I_LNXG) + l * 1024; const float* lb = PIN(I_LNXB) + l * 1024;
    for (int i0 = gtid; i0 < MTOT * 256; i0 += 2 * gthreads) {
        f32x4 y[2], vv[2], ga[2]; float bon[2]; int mm[2], cc[2]; bool ok[2];
#pragma unroll
        for (int u = 0; u < 2; ++u) {
            const int i = i0 + u * gthreads; ok[u] = i < MTOT * 256; const int ii = ok[u] ? i : i0;
            const int m = ii >> 8, c = (ii & 255) * 4, h = c >> 6; mm[u] = m; cc[u] = c;
            y[u] = *(const f32x4*)(ybuf + (size_t)m * 1024 + c);
            vv[u] = ld4bf(scr + ((size_t)m * 16 + h) * REC + 5 * 64 + (c & 63)); bon[u] = rkb[((size_t)m * 16 + h) * 4];
            ga[u] = ld4bf(proj + (size_t)m * DINP + C_GA + c);
        }
#pragma unroll
        for (int u = 0; u < 2; ++u) {
            const int m = mm[u], c = cc[u];
            const float mean = allreduce16(y[u][0] + y[u][1] + y[u][2] + y[u][3]) * (1.f / 64.f);
            const f32x4 d = y[u] - mean;
            const float var = allreduce16(d[0] * d[0] + d[1] * d[1] + d[2] * d[2] + d[3] * d[3]) * (1.f / 64.f);
            const float rs = rsqrtf(var + 64e-5f);
            const f32x4 g4 = *(const f32x4*)(lg + c), b4 = *(const f32x4*)(lb + c);
            f32x4 o;
#pragma unroll
            for (int e = 0; e < 4; ++e) o[e] = (d[e] * rs * g4[e] + b4[e] + bon[u] * vv[u][e]) * siluf(ga[u][e]);
            if (ok[u]) st4bf(cat + (size_t)m * DM + c, o);
        }
    }
}

DEVINL void phase_final(const Params& p, int z, int wv) {
    LAUNDER_PTRS;
    const int gtid = (int)(blockIdx.x + z) * 512 + mk_tid(wv, z), gthreads = gridDim.x * 512;
    const float* xf = (const float*)(PWS + WS_XF); const float* ssq = (const float*)(PWS + WS_SSQ) + 4 * MTOT; const float* fg = PIN(I_FNORMG);
    for (int i0 = gtid; i0 < MTOT * 512; i0 += 4 * gthreads) {
        f32x4 xv[4]; float sq[4];
#pragma unroll
        for (int u = 0; u < 4; ++u) { const int i = i0 + u * gthreads; const int ii = i < MTOT * 512 ? i : i0; xv[u] = *(const f32x4*)(xf + (size_t)(ii >> 9) * DM + (ii & 511) * 4); sq[u] = ssq[ii >> 9]; }
#pragma unroll
        for (int u = 0; u < 4; ++u) { const int i = i0 + u * gthreads; if (i < MTOT * 512) { const int m = i >> 9, c = (i & 511) * 4;
            *(f32x4*)(POUT + (size_t)m * DM + c) = xv[u] * rsqrtf(sq[u] * (1.f / 2048.f) + 1e-6f) * *(const f32x4*)(fg + c); } }
    }
}

#ifndef REP_P0
#define REP_P0 1
#endif
#ifndef REP_G1
#define REP_G1 1
#endif
#ifndef REP_2A
#define REP_2A 1
#endif
#ifndef REP_2B
#define REP_2B 1
#endif
#ifndef REP_2C
#define REP_2C 1
#endif
#ifndef REP_SYNC
#define REP_SYNC 0
#endif
#define FRESH_Z(z) int z; asm volatile("s_mov_b32 %0, 0" : "=s"(z))
__global__ void __launch_bounds__(512, 2) hybrid_fwd(Params p) {
    extern __shared__ __attribute__((aligned(16))) unsigned char lds[];
    cg::grid_group grid = cg::this_grid();
    const int wv = __builtin_amdgcn_readfirstlane((int)threadIdx.x >> 6);
    volatile unsigned* bst = (volatile unsigned*)(lds + 131072);
    {
        FRESH_Z(z); LAUNDER_PTRS; const int tid = mk_tid(wv, z);
        if ((int)(blockIdx.x + z) == 0) for (int i = tid; i < XCD_BAR_WORDS; i += 512) ((unsigned*)(PWS + WS_BAR))[i] = 0u;
        if (tid < 2) bst[tid] = 0u;
    }
    for (int rep = 0; rep < REP_P0; ++rep) { FRESH_Z(z); phase0(p, lds, z, wv); }
    grid.sync();
#define GRID_BAR() do { FRESH_Z(zb); unsigned char* wsb_ = p.ws; asm volatile("" : "+s"(wsb_)); xcd_barrier((unsigned*)(wsb_ + WS_BAR), bst, mk_tid(wv, zb)); } while (0)
    for (int l = 0; l < NL; ++l) {
        for (int rep = 0; rep < REP_G1; ++rep) {
            FRESH_Z(z); LAUNDER_PTRS;
            pg8::Gemm g; g.A = (const bf16_t*)(PWS + WS_XB); g.Bt = (const bf16_t*)(PWS + WS_WINT) + (size_t)l * DINP * DM; g.M = MTOT; g.N = DINP; g.K = DM;
            pg8::StaticOrder S; S.init(MTOT, DINP, (int)gridDim.x, (int)(blockIdx.x + z));
            EpiProj E; E.O = (bf16_t*)(PWS + WS_PROJ); E.ssq = (const float*)(PWS + WS_SSQ) + l * MTOT;
            pg8::gemm_phase<EpiProj, pg8::StaticOrder, false>((PG8_LAS unsigned char*)lds, g, S, E, nullptr, mk_tid(wv, z));
        }
        GRID_BAR();
        for (int rep = 0; rep < REP_2A; ++rep) { FRESH_Z(z); phase2a(p, lds, l, z, wv); }
        GRID_BAR();
        for (int rep = 0; rep < REP_2B; ++rep) { FRESH_Z(z); phase2b(p, lds, l, z, wv); }
        GRID_BAR();
        for (int rep = 0; rep < REP_2C; ++rep) { FRESH_Z(z); phase2c(p, l, z, wv); }
        for (int rep = 0; rep < REP_SYNC; ++rep) GRID_BAR();
        GRID_BAR();
        {
            FRESH_Z(z); LAUNDER_PTRS;
            pg8::Gemm g; g.A = (const bf16_t*)(PWS + WS_CAT); g.Bt = (const bf16_t*)(PWS + WS_WOUTT) + (size_t)l * DM * DM; g.M = MTOT; g.N = DM; g.K = DM;
            HalfOrder S; S.init((int)gridDim.x, (int)(blockIdx.x + z));
            EpiRes E; E.srcP = l == 0 ? PIN(I_XP) : (const float*)(PWS + WS_XF); E.srcS = l == 0 ? PIN(I_XS) : (const float*)(PWS + WS_XF) + (size_t)MP * DM;
            E.xf = (float*)(PWS + WS_XF); E.xb = l + 1 < NL ? (bf16_t*)(PWS + WS_XB) : nullptr; E.ssq_next = (float*)(PWS + WS_SSQ) + (l + 1) * MTOT;
            pg8::gemm_phase<EpiRes, HalfOrder, false>((PG8_LAS unsigned char*)lds, g, S, E, nullptr, mk_tid(wv, z));
        }
        if (l + 1 < NL) {
            FRESH_Z(z);
            const int G = (int)gridDim.x, bidz = (int)(blockIdx.x + z), nb2 = (G < 320 && 320 - G < G) ? 320 - G : 0;
            if (bidz >= nb2) convert_layer(p, lds, l + 1, bidz - nb2, G - nb2, z, wv);
        }
        GRID_BAR();
    }
    { FRESH_Z(z); phase_final(p, z, wv); }
}

extern "C" void kernel_launch(void* const* d_in, const int* in_sizes, int n_in, void* d_out, int out_size, void* d_ws, size_t ws_size, hipStream_t stream) {
    static int grid = 0;
    if (grid == 0) {
        if (n_in != 24 || (size_t)out_size != O_END || ws_size < WS_END) { fprintf(stderr, "kernel_launch: unexpected shapes (n_in %d out %d ws %zu, need ws >= %zu)\n", n_in, out_size, ws_size, (size_t)WS_END); grid = -1; return; }
        int dev = 0, cus = 0, per_cu = 0;
        (void)hipGetDevice(&dev); (void)hipDeviceGetAttribute(&cus, hipDeviceAttributeMultiprocessorCount, dev);
        if (hipFuncSetAttribute((const void*)hybrid_fwd, hipFuncAttributeMaxDynamicSharedMemorySize, LDS_BYTES) != hipSuccess) { fprintf(stderr, "kernel_launch: hipFuncSetAttribute failed\n"); grid = -1; return; }
        if (hipOccupancyMaxActiveBlocksPerMultiprocessor(&per_cu, (const void*)hybrid_fwd, 512, LDS_BYTES) != hipSuccess || per_cu < 1) { fprintf(stderr, "kernel_launch: occupancy query says %d blocks per CU\n", per_cu); per_cu = 1; }
        (void)hipGetLastError();
        grid = cus;
        if (grid > 256) grid = 256;
    }
    if (grid < 0) return;
    Params p{};
    for (int i = 0; i < 24; ++i) p.in[i] = (const float*)d_in[i];
    p.out = (float*)d_out; p.ws = (unsigned char*)d_ws;
    void* args[] = {&p};
    hipError_t e = hipLaunchCooperativeKernel((const void*)hybrid_fwd, dim3(grid), dim3(512), args, LDS_BYTES, stream);
    if (e != hipSuccess) fprintf(stderr, "kernel_launch: cooperative launch failed: %s (grid %d)\n", hipGetErrorString(e), grid);
}
```

```cpp
#include <hip/hip_runtime.h>
#include <hip/hip_cooperative_groups.h>
#include <cstdio>
namespace cg = cooperative_groups;
namespace pg8 {
#define PG8_LAS __attribute__((address_space(3)))
typedef unsigned short bf16_t;
typedef short bf16x8 __attribute__((ext_vector_type(8)));
typedef float f32x4 __attribute__((ext_vector_type(4)));
typedef unsigned u32x4 __attribute__((ext_vector_type(4)));
constexpr int BM = 256, BK = 64, HALF = 128, HTB = HALF * BK * 2  , STAGE_BYTES = 8 * HTB, NXCD = 8, WGM = 8;

__host__ __device__ __forceinline__ int lds_byte(int r, int c) { const int st = (r >> 4) * 2 + (c >> 5), rr = r & 15, cc = c & 31, ob = rr * 64 + cc * 2; return st * 1024 + (ob ^ (((ob >> 9) & 1) << 5)); }
__host__ __device__ __forceinline__ void stage_rc(int b, int& R, int& C) { const int st = b / 1024, sb = b % 1024, swz = sb ^ (((sb >> 9) & 1) << 5); R = (st >> 1) * 16 + swz / 64; C = (st & 1) * 32 + (swz % 64) / 2; }
__host__ __device__ __forceinline__ int perm32(int rho) { const int n = rho >> 4, i = rho & 15; return 8 * (i >> 2) + 4 * n + (i & 3); }

struct Unit { int pm, pn; };
struct Gemm { const bf16_t* A; const bf16_t* Bt; int M, N, K; };

struct StaticOrder {
    int nM, nN, nwg, G, c;
    __host__ __device__ void init(int M, int N, int G_, int c_) { nM = M / BM; nN = N / BM; nwg = nM * nN; G = G_; c = c_; }
    __host__ __device__ bool next(int i, Unit& u) const {
        const long L = (long)i * G + c; if (L >= nwg) return false;
        int wgid = (int)L; { const int q = nwg / NXCD, r = nwg % NXCD, xcd = wgid % NXCD, off = wgid / NXCD; wgid = (xcd < r ? xcd * (q + 1) : r * (q + 1) + (xcd - r) * q) + off; }
        const int nig = WGM * nN, gid = wgid / nig, fm = gid * WGM, gsz = (nM - fm) < WGM ? (nM - fm) : WGM;
        u.pm = fm + ((wgid % nig) % gsz); u.pn = (wgid % nig) / gsz; return true;
    }
    __device__ __forceinline__ void a_ready(const Unit&) const {}
    __device__ __forceinline__ void done(const Unit&) const {}
};

template <class Epi, class Sched, bool STAMP = false>
__device__ __forceinline__ void gemm_phase(PG8_LAS unsigned char* lds, const Gemm g, const Sched& S, const Epi& E, unsigned long long* stamps, int zz) {
    const int tid = zz, wid = __builtin_amdgcn_readfirstlane(tid >> 6), lane = tid & 63, wr = wid >> 2, wc = wid & 3, fr = lane & 15, fq = lane >> 4;
    const int K = g.K, nt = K / BK;
    int ts_lo = 0, ts_hi = 0, nts = 0; const unsigned long long rt_entry = STAMP ? (unsigned long long)wall_clock64() : 0ull;
#define PG8_STAMP() do { if (STAMP && wid == 0 && nts < 64) { const unsigned long long _c = (unsigned long long)clock64(); \
        ts_lo = (lane == nts) ? (int)(unsigned)_c : ts_lo; ts_hi = (lane == nts) ? (int)(unsigned)(_c >> 32) : ts_hi; ++nts; } } while (0)
    PG8_STAMP();
    unsigned voffA[2], voffB[2];
#pragma unroll
    for (int i = 0; i < 2; ++i) { int R, C; stage_rc(tid * 16 + i * 8192, R, C); const int Rb = Epi::PERM ? ((R & ~31) + perm32(R & 31)) : R;
        voffA[i] = (unsigned)(R * K + C) * 2u; voffB[i] = (unsigned)(Rb * K + C) * 2u; }
    const size_t kstep = (size_t)(BK * 2);
    const size_t hstep = (size_t)HALF * K * 2;
    const size_t tstep = 2 * hstep;
    const unsigned ldsw = (unsigned)wid * 1024u;
    const int aoff = lds_byte(wr * 64 + fr, fq * 8), boff = lds_byte(wc * 32 + fr, fq * 8);
#define PG8_SA(b, h) (((b) * 2 + (h)) * HTB)
#define PG8_SB(b, h) ((4 + (b) * 2 + (h)) * HTB)
#define PG8_STAGE(bufoff, gbase, voff) do { _Pragma("unroll") for (int _i = 0; _i < 2; ++_i) \
        __builtin_amdgcn_global_load_lds((const unsigned*)((const char*)(gbase) + (voff)[_i]), (PG8_LAS unsigned*)(lds + (bufoff) + ldsw + _i * 8192), 16, 0, 0); } while (0)
#define PG8_LDA(dst, b, h) do { _Pragma("unroll") for (int m = 0; m < 4; ++m) _Pragma("unroll") for (int k = 0; k < 2; ++k) dst[m][k] = *(const PG8_LAS bf16x8*)(lds + PG8_SA(b, h) + aoff + m * 2048 + k * 1024); } while (0)
#define PG8_LDB(dst, b, h) do { _Pragma("unroll") for (int n = 0; n < 2; ++n) _Pragma("unroll") for (int k = 0; k < 2; ++k) dst[n][k] = *(const PG8_LAS bf16x8*)(lds + PG8_SB(b, h) + boff + n * 2048 + k * 1024); } while (0)
#define PG8_MMA(ai, bj, At, Bt) do { __builtin_amdgcn_s_setprio(1); _Pragma("unroll") for (int m = 0; m < 4; ++m) _Pragma("unroll") for (int n = 0; n < 2; ++n) _Pragma("unroll") for (int k = 0; k < 2; ++k) \
        acc[ai][bj][m][n] = __builtin_amdgcn_mfma_f32_16x16x32_bf16(Bt[n][k], At[m][k], acc[ai][bj][m][n], 0, 0, 0); __builtin_amdgcn_s_setprio(0); } while (0)
#define PG8_WAIT_V(n) asm volatile("s_waitcnt vmcnt(" #n ")" ::: "memory")
#define PG8_WAIT_L(n) asm volatile("s_waitcnt lgkmcnt(" #n ")" ::: "memory")
#define PG8_BAR __builtin_amdgcn_s_barrier()
#define PG8_SCHED __builtin_amdgcn_sched_barrier(0)
    Unit cur, nxt; int ui = 0;
    if (!S.next(0, cur)) return;
    f32x4 acc[2][2][4][2];
#pragma unroll
    for (int a = 0; a < 2; ++a)
#pragma unroll
        for (int b = 0; b < 2; ++b)
#pragma unroll
            for (int m = 0; m < 4; ++m)
#pragma unroll
                for (int n = 0; n < 2; ++n) acc[a][b][m][n] = (f32x4){0.f, 0.f, 0.f, 0.f};
    bf16x8 At[4][2], B0[2][2], B1[2][2];
    const char* cA = (const char*)g.A + (size_t)cur.pm * tstep; const char* cB = (const char*)g.Bt + (size_t)cur.pn * tstep;
    S.a_ready(cur);
    PG8_STAGE(PG8_SB(0, 0), cB, voffB); PG8_STAGE(PG8_SA(0, 0), cA, voffA); PG8_STAGE(PG8_SB(0, 1), cB + hstep, voffB); PG8_STAGE(PG8_SA(0, 1), cA + hstep, voffA);
    if (wr == 1) PG8_BAR;
    PG8_WAIT_V(4); PG8_BAR;
    PG8_STAGE(PG8_SB(1, 0), cB + kstep, voffB); PG8_STAGE(PG8_SA(1, 0), cA + kstep, voffA); PG8_STAGE(PG8_SB(1, 1), cB + hstep + kstep, voffB);
    PG8_WAIT_V(6); PG8_BAR;
    PG8_STAMP();
    for (;;) {
        const bool has_next = S.next(ui + 1, nxt);
        const char* nA = has_next ? (const char*)g.A + (size_t)nxt.pm * tstep : cA; const char* nB = has_next ? (const char*)g.Bt + (size_t)nxt.pn * tstep : cB;
        for (int t = 0; t < nt; t += 2) {
            const bool last = (t == nt - 2);
            const char* a1 = cA + (size_t)(t + 1) * kstep;
            const char* a2 = last ? nA : cA + (size_t)(t + 2) * kstep; const char* b2 = last ? nB : cB + (size_t)(t + 2) * kstep;
            const char* a3 = a2 + kstep; const char* b3 = b2 + kstep;
            if (last && has_next) S.a_ready(nxt);
            PG8_LDB(B0, 0, 0); PG8_SCHED; PG8_LDA(At, 0, 0); PG8_STAGE(PG8_SA(1, 1), a1 + hstep, voffA);
            PG8_WAIT_L(8); PG8_BAR; PG8_WAIT_L(0); PG8_MMA(0, 0, At, B0); PG8_BAR; PG8_SCHED;
            PG8_LDB(B1, 0, 1); PG8_STAGE(PG8_SB(0, 0), b2, voffB);
            PG8_BAR; PG8_WAIT_L(0); PG8_MMA(0, 1, At, B1); PG8_BAR;
            PG8_LDA(At, 0, 1); PG8_STAGE(PG8_SA(0, 0), a2, voffA);
            PG8_BAR; PG8_WAIT_L(0); PG8_MMA(1, 0, At, B0); PG8_BAR; PG8_SCHED;
            PG8_STAGE(PG8_SB(0, 1), b2 + hstep, voffB);
            PG8_WAIT_V(6); PG8_BAR; PG8_MMA(1, 1, At, B1); PG8_BAR;
            PG8_LDB(B0, 1, 0); PG8_SCHED; PG8_LDA(At, 1, 0); PG8_STAGE(PG8_SA(0, 1), a2 + hstep, voffA);
            PG8_WAIT_L(8); PG8_BAR; PG8_WAIT_L(0); PG8_MMA(0, 0, At, B0); PG8_BAR; PG8_SCHED;
            PG8_LDB(B1, 1, 1); PG8_STAGE(PG8_SB(1, 0), b3, voffB);
            PG8_BAR; PG8_WAIT_L(0); PG8_MMA(0, 1, At, B1); PG8_BAR;
            PG8_LDA(At, 1, 1); PG8_STAGE(PG8_SA(1, 0), a3, voffA);
            PG8_BAR; PG8_WAIT_L(0); PG8_MMA(1, 0, At, B0); PG8_BAR; PG8_SCHED;
            PG8_STAGE(PG8_SB(1, 1), b3 + hstep, voffB);
            PG8_WAIT_V(6); PG8_BAR; PG8_MMA(1, 1, At, B1); PG8_BAR;
        }
        PG8_STAMP();
        if constexpr (!Epi::AFTER_DRAIN) { E(acc, cur, wr, wc, fr, fq); S.done(cur); }
        PG8_STAMP();
        if (!has_next) break;
#pragma unroll
        for (int a = 0; a < 2; ++a)
#pragma unroll
            for (int b = 0; b < 2; ++b)
#pragma unroll
                for (int m = 0; m < 4; ++m)
#pragma unroll
                    for (int n = 0; n < 2; ++n) acc[a][b][m][n] = (f32x4){0.f, 0.f, 0.f, 0.f};
        cur = nxt; cA = nA; cB = nB; ++ui;
    }
    PG8_WAIT_V(0);
    if (wr == 0) PG8_BAR;
    PG8_BAR;
    if constexpr (Epi::AFTER_DRAIN) { E.fused(acc, cur, wr, wc, fr, fq, lds, wid, lane); S.done(cur); }
    PG8_STAMP();
    if (STAMP && wid == 0) { stamps[lane] = lane < nts ? (((unsigned long long)(unsigned)ts_hi << 32) | (unsigned)ts_lo) : 0ull;
        if (lane == 62) stamps[62] = rt_entry; if (lane == 63) stamps[63] = (unsigned long long)wall_clock64(); }
#undef PG8_STAMP
#undef PG8_SA
#undef PG8_SB
#undef PG8_STAGE
#undef PG8_LDA
#undef PG8_LDB
#undef PG8_MMA
#undef PG8_WAIT_V
#undef PG8_WAIT_L
#undef PG8_BAR
#undef PG8_SCHED
}
}
using pg8::bf16_t; using pg8::bf16x8; using pg8::f32x4; using pg8::u32x4;
typedef unsigned u32x2 __attribute__((ext_vector_type(2)));
#define DEVINL __device__ __forceinline__
#ifndef REP_CH
#define REP_CH 1
#endif
#ifndef REP_PL
#define REP_PL 1
#endif
#ifndef REP_PR1
#define REP_PR1 1
#endif
#ifndef REP_PR2
#define REP_PR2 1
#endif
#ifndef REP_SP
#define REP_SP 1
#endif
#ifndef REP_PS
#define REP_PS 1
#endif
#ifndef REP_PR
#define REP_PR 1
#endif
DEVINL int mk_tid(int wv, int z) { int lane; asm volatile("v_mbcnt_lo_u32_b32 %0, -1, 0\n\tv_mbcnt_hi_u32_b32 %0, -1, %0" : "=v"(lane)); return (wv + z) * 64 + lane; }
#define PIN(i) ((const float*)(p.in[(i) + z]))
#define PWS ws_
#define POUT out_
#define LAUNDER_PTRS GLOBAL_AS unsigned char* ws0_ = p.ws; GLOBAL_AS float* out0_ = p.out; asm volatile("" : "+s"(ws0_), "+s"(out0_)); unsigned char* ws_ = (unsigned char*)ws0_; float* out_ = (float*)out0_

constexpr int DM = 2048, MTOT = 9216, MP = 8192, DIN = 6784, DINP = 6912, NL = 4, SHW = 3200;
constexpr int C_GA = 3200, C_UB = 4224, C_GB = 4736, C_UC = 5248, C_VC = 5760, C_GC = 6272;
constexpr size_t O_YP = 0, O_PSHIFT = 18874368, O_PWKV = 18925568, O_PPOOL = 19974144, O_SSHIFT = 20097024, O_SWKV = 21735424, O_SPOOL = 55289856, O_SV = 59222016, O_END = 61319168;
constexpr size_t SCAN_STRIDE = (size_t)MTOT * 1024;
constexpr size_t WS_WINT = 0;
constexpr size_t WS_WOUTT = WS_WINT + (size_t)NL * DINP * DM * 2;
constexpr size_t WS_XB = WS_WOUTT + (size_t)NL * DM * DM * 2;
constexpr size_t WS_XF = WS_XB + (size_t)MTOT * DM * 2;
constexpr size_t WS_PROJ = WS_XF + (size_t)MTOT * DM * 4;
constexpr size_t WS_CAT = WS_PROJ + (size_t)MTOT * DINP * 2;
constexpr size_t WS_SCAN = WS_CAT + (size_t)MTOT * DM * 2;
constexpr size_t WS_Y = WS_SCAN + 6 * SCAN_STRIDE * 4;
constexpr size_t WS_RKB = WS_Y + SCAN_STRIDE * 4;
constexpr size_t WS_SSQ = WS_RKB + (size_t)MTOT * 16 * 4 * 4;
constexpr size_t WS_WUPT = WS_SSQ + (size_t)5 * MTOT * 4;
constexpr size_t WS_AUPT = WS_WUPT + (size_t)NL * 1024 * 64 * 2;
constexpr size_t WS_POOLWT = WS_AUPT + (size_t)NL * 1024 * 64 * 2;
constexpr size_t WS_PREV = WS_POOLWT + (size_t)NL * 4 * 128 * 128 * 2;
constexpr size_t WS_ZROW = WS_PREV + (size_t)NL * 128 * SHW * 2;
constexpr size_t WS_BAR = WS_ZROW + 8192;
constexpr size_t WS_END = WS_BAR + 16384;
constexpr int REC = 6 * 64;
constexpr int LDS_BYTES = 131072 + 64;

#define GLOBAL_AS __attribute__((address_space(1)))
struct Params { GLOBAL_AS const float* in[24]; GLOBAL_AS float* out; GLOBAL_AS unsigned char* ws; };
enum { I_XP = 0, I_XS, I_SSHIFT, I_SWKV, I_SPOOL, I_NORMG, I_FNORMG, I_WIN, I_MU, I_W0, I_WUP, I_A0, I_AUP, I_KK, I_KA, I_RK, I_LNXG, I_LNXB, I_POOLW, I_POOLS, I_GLNG, I_GWS, I_GB, I_WOUT };

DEVINL unsigned cvt_pk(float lo, float hi) { unsigned r; asm("v_cvt_pk_bf16_f32 %0, %1, %2" : "=v"(r) : "v"(lo), "v"(hi)); return r; }
DEVINL bf16_t f2bf(float f) { unsigned u = __float_as_uint(f); u += 0x7FFFu + ((u >> 16) & 1u); return (bf16_t)(u >> 16); }
DEVINL float bf2f(bf16_t b) { return __uint_as_float(((unsigned)b) << 16); }
DEVINL f32x4 ld4bf(const bf16_t* p) { const u32x2 w = *(const u32x2*)p; f32x4 r; r[0] = __uint_as_float(w.x << 16); r[1] = __uint_as_float(w.x & 0xFFFF0000u); r[2] = __uint_as_float(w.y << 16); r[3] = __uint_as_float(w.y & 0xFFFF0000u); return r; }
DEVINL void st4bf(bf16_t* p, f32x4 v) { u32x2 w; w.x = cvt_pk(v[0], v[1]); w.y = cvt_pk(v[2], v[3]); *(u32x2*)p = w; }
DEVINL float siluf(float x) { return x * __builtin_amdgcn_rcpf(1.f + __expf(-x)); }
template <int CTRL> DEVINL float dpp_add(float x) { return x + __int_as_float(__builtin_amdgcn_update_dpp(0, __float_as_int(x), CTRL, 0xF, 0xF, false)); }
DEVINL float allreduce16(float x) { x = dpp_add<0x128>(x); x = dpp_add<0x124>(x); x = dpp_add<0x122>(x); x = dpp_add<0x121>(x); return x; }
DEVINL float xq_sum(float x) { x += __shfl_xor(x, 16); x += __shfl_xor(x, 32); return x; }
DEVINL float wave_sum(float x) { for (int o = 32; o > 0; o >>= 1) x += __shfl_xor(x, o); return x; }
DEVINL f32x4 mfma16(bf16x8 a, bf16x8 b, f32x4 c) { return __builtin_amdgcn_mfma_f32_16x16x32_bf16(a, b, c, 0, 0, 0); }


#define XB_TMO      128
#define XB_XCNT(j)  (256  + 64 * (j))
#define XB_XSUB(j)  (1280 + 64 * (j))
#define XB_XGEN(j)  (2304 + 64 * (j))
#define XB_TOP      3328
#define XB_TOPGEN   3392
#define XCD_BAR_WORDS 3456
#define XB_SPIN_CAP (1u << 18)
DEVINL unsigned xb_ld(unsigned* p)              { return __hip_atomic_load(p, __ATOMIC_RELAXED, __HIP_MEMORY_SCOPE_AGENT); }
DEVINL unsigned xb_add(unsigned* p, unsigned v) { return __hip_atomic_fetch_add(p, v, __ATOMIC_RELAXED, __HIP_MEMORY_SCOPE_AGENT); }
DEVINL unsigned xb_xcc_id() { return (unsigned)__builtin_amdgcn_s_getreg((3 << 11) | 20) & 0xFu; }
#define XB_SPIN(cond, bar) do { unsigned _sp = 0; while (cond) { __builtin_amdgcn_s_sleep(1); \
    if ((++_sp & 255u) == 0u) { if (xb_ld(&(bar)[XB_TMO])) break; if (_sp > XB_SPIN_CAP) { atomicAdd(&(bar)[XB_TMO], 1u); break; } } } } while (0)
DEVINL void xcd_barrier_complete(unsigned* bar, unsigned x, unsigned& nloc, unsigned& nx) {
    const unsigned G = gridDim.x;
    unsigned sum, cnt, mine, sp = 0u;
    for (;;) {
        sum = 0u; cnt = 0u; mine = 0u;
#pragma unroll
        for (unsigned j = 0; j < 16; ++j) { const unsigned c = xb_ld(&bar[XB_XCNT(j)]); sum += c; cnt += (c > 0u) ? 1u : 0u; mine = (j == x) ? c : mine; }
        if (sum == G) break;
        __builtin_amdgcn_s_sleep(1);
        if ((++sp & 255u) == 0u) { if (xb_ld(&bar[XB_TMO])) break; if (sp > XB_SPIN_CAP) { atomicAdd(&bar[XB_TMO], 1u); break; } }
    }
    nloc = mine > 0u ? mine : 1u; nx = cnt > 0u ? cnt : 1u;
}
DEVINL void xcd_barrier(unsigned* bar, volatile unsigned* st, int tid) {
    asm volatile("s_waitcnt vmcnt(0)" ::: "memory");
    __syncthreads();
    if (tid == 0) {
        const unsigned x = xb_xcc_id();
        __builtin_amdgcn_s_waitcnt(0);
        unsigned nloc = st[0], nx = st[1];
        if (nloc == 0u) { (void)xb_add(&bar[XB_XCNT(x)], 1u); xcd_barrier_complete(bar, x, nloc, nx); st[0] = nloc; st[1] = nx; }
        const unsigned old = xb_add(&bar[XB_XSUB(x)], 1u);
        const unsigned gen = old / nloc;
        if (old + 1u == (gen + 1u) * nloc) {
            __builtin_amdgcn_fence(__ATOMIC_RELEASE, "agent");
            asm volatile("s_waitcnt vmcnt(0)" ::: "memory");
            const unsigned og = xb_add(&bar[XB_TOP], 1u);
            const unsigned tg = og / nx;
            if (og + 1u == (tg + 1u) * nx) xb_add(&bar[XB_TOPGEN], 1u);
            else XB_SPIN(xb_ld(&bar[XB_TOPGEN]) == tg, bar);
            __builtin_amdgcn_fence(__ATOMIC_ACQUIRE, "agent");
            xb_add(&bar[XB_XGEN(x)], 1u);
            asm volatile("s_waitcnt vmcnt(0)" ::: "memory");
        } else {
            XB_SPIN(xb_ld(&bar[XB_XGEN(x)]) == gen, bar);
            __builtin_amdgcn_fence(__ATOMIC_ACQUIRE, "agent");
            asm volatile("s_waitcnt vmcnt(0)" ::: "memory");
        }
    }
    __syncthreads();
}

struct EpiProj {
    static constexpr bool PERM = true, AFTER_DRAIN = false;
    bf16_t* O; const float* ssq;
    DEVINL void operator()(const f32x4 (&acc)[2][2][4][2], const pg8::Unit& u, int wr, int wc, int fr, int fq) const {
        const int row0 = u.pm * 256 + wr * 64 + fr, col0 = u.pn * 256 + wc * 32 + 8 * fq;
#pragma unroll
        for (int ai = 0; ai < 2; ++ai)
#pragma unroll
            for (int m = 0; m < 4; ++m) {
                const int row = row0 + ai * 128 + m * 16;
                const float rs = rsqrtf(ssq[row] * (1.0f / 2048.0f) + 1e-6f);
                bf16_t* rowp = O + (size_t)row * DINP + col0;
#pragma unroll
                for (int bj = 0; bj < 2; ++bj) {
                    const f32x4 v0 = acc[ai][bj][m][0] * rs, v1 = acc[ai][bj][m][1] * rs;
                    u32x4 w; w.x = cvt_pk(v0[0], v0[1]); w.y = cvt_pk(v0[2], v0[3]); w.z = cvt_pk(v1[0], v1[1]); w.w = cvt_pk(v1[2], v1[3]);
                    *(u32x4*)(rowp + bj * 128) = w;
                }
            }
    }
};
struct EpiRes {
    static constexpr bool PERM = true, AFTER_DRAIN = false;
    const float* srcP; const float* srcS; float* xf; bf16_t* xb; float* ssq_next;
    DEVINL void operator()(const f32x4 (&acc)[2][2][4][2], const pg8::Unit& u, int wr, int wc, int fr, int fq) const {
        const int row0 = u.pm * 256 + wr * 64 + fr, col0 = u.pn * 256 + wc * 32 + 8 * fq;
#pragma unroll
        for (int ai = 0; ai < 2; ++ai)
#pragma unroll
            for (int m = 0; m < 4; ++m) {
                const int row = row0 + ai * 128 + m * 16;
                const float* src = (row < MP ? srcP + (size_t)row * DM : srcS + (size_t)(row - MP) * DM) + col0;
                float* dst = xf + (size_t)row * DM + col0; bf16_t* dsb = xb + (size_t)row * DM + col0;
                float part = 0.f;
#pragma unroll
                for (int bj = 0; bj < 2; ++bj) {
                    const f32x4 y0 = *(const f32x4*)(src + bj * 128) + acc[ai][bj][m][0], y1 = *(const f32x4*)(src + bj * 128 + 4) + acc[ai][bj][m][1];
                    *(f32x4*)(dst + bj * 128) = y0; *(f32x4*)(dst + bj * 128 + 4) = y1;
                    u32x4 w; w.x = cvt_pk(y0[0], y0[1]); w.y = cvt_pk(y0[2], y0[3]); w.z = cvt_pk(y1[0], y1[1]); w.w = cvt_pk(y1[2], y1[3]);
                    if (xb) *(u32x4*)(dsb + bj * 128) = w;
                    part += y0[0] * y0[0] + y0[1] * y0[1] + y0[2] * y0[2] + y0[3] * y0[3] + y1[0] * y1[0] + y1[1] * y1[1] + y1[2] * y1[2] + y1[3] * y1[3];
                }
                part = xq_sum(part);
                if (fq == 0) atomicAdd(ssq_next + row, part);
            }
    }
};
DEVINL void convert_layer(const Params& p, unsigned char* lds, int l, int vb, int vG, int z, int wv) {
    LAUNDER_PTRS;
    const int tid = mk_tid(wv, z);
    float* tile = (float*)lds;
    bf16_t* WinT = (bf16_t*)(PWS + WS_WINT) + (size_t)l * DINP * DM; bf16_t* WoutT = (bf16_t*)(PWS + WS_WOUTT) + (size_t)l * DM * DM;
    constexpr int NT_IN = 32 * 106, NT_OUT = 32 * 32;
    for (int it = vb; it < NT_IN + NT_OUT; it += vG) {
        int kt, nt, ld; const float* src; const float* gs; bf16_t* dst;
        if (it < NT_IN) { nt = it % 106; kt = it / 106; ld = DIN; src = PIN(I_WIN) + (size_t)l * DM * DIN; gs = PIN(I_NORMG) + l * DM; dst = WinT; }
        else { const int r = it - NT_IN; nt = r % 32; kt = r / 32; ld = DM; src = PIN(I_WOUT) + (size_t)l * DM * DM; gs = nullptr; dst = WoutT; }
#pragma unroll
        for (int ps = 0; ps < 2; ++ps) {
            const int row = (tid >> 4) + ps * 32, c4 = (tid & 15) * 4;
            const float4 v = *(const float4*)(src + (size_t)(kt * 64 + row) * ld + nt * 64 + c4);
            const float s = gs ? gs[kt * 64 + row] : 1.f;
            float* tp = tile + row * 65 + c4; tp[0] = v.x * s; tp[1] = v.y * s; tp[2] = v.z * s; tp[3] = v.w * s;
        }
        __syncthreads();
        { const int n = tid >> 3, kg = (tid & 7) * 8; const float* tp = tile + kg * 65 + n;
          u32x4 w; w.x = cvt_pk(tp[0], tp[65]); w.y = cvt_pk(tp[130], tp[195]); w.z = cvt_pk(tp[260], tp[325]); w.w = cvt_pk(tp[390], tp[455]);
          *(u32x4*)(dst + (size_t)(nt * 64 + n) * DM + kt * 64 + kg) = w; }
        __syncthreads();
    }
    for (int i = vb * 512 + tid; i < 128 * 256; i += vG * 512) *(u32x4*)(WinT + (size_t)DIN * DM + (size_t)i * 8) = (u32x4){0u, 0u, 0u, 0u};
}

DEVINL void phase0(const Params& p, unsigned char* lds, int z, int wv) {
    LAUNDER_PTRS;
    const int tid = mk_tid(wv, z), G = gridDim.x, bid = (int)(blockIdx.x + z), lane = tid & 63;
    convert_layer(p, lds, 0, bid, G, z, wv);
    const int gtid = bid * 512 + tid, gthreads = G * 512;
    bf16_t* xb = (bf16_t*)(PWS + WS_XB); float* ssq = (float*)(PWS + WS_SSQ);
    for (int m = bid * 8 + (tid >> 6); m < MTOT; m += G * 8) {
        const float* src = m < MP ? PIN(I_XP) + (size_t)m * DM : PIN(I_XS) + (size_t)(m - MP) * DM;
        float ss = 0.f;
#pragma unroll
        for (int i = 0; i < 8; ++i) { const f32x4 v = *(const f32x4*)(src + i * 256 + lane * 4); ss += v[0] * v[0] + v[1] * v[1] + v[2] * v[2] + v[3] * v[3]; st4bf(xb + (size_t)m * DM + i * 256 + lane * 4, v); }
        ss = wave_sum(ss);
        if (lane == 0) ssq[m] = ss;
    }
    for (int i = gtid; i < 4 * MTOT; i += gthreads) ssq[MTOT + i] = 0.f;
    {
        bf16_t* prevb = (bf16_t*)(PWS + WS_PREV);
        for (int i = gtid; i < NL * 128 * SHW; i += gthreads) prevb[i] = f2bf(PIN(I_SSHIFT)[i]);
        for (int i = gtid; i < SHW; i += gthreads) ((bf16_t*)(PWS + WS_ZROW))[i] = 0;
    }
    bf16_t* wupT = (bf16_t*)(PWS + WS_WUPT); bf16_t* aupT = (bf16_t*)(PWS + WS_AUPT); bf16_t* poolwT = (bf16_t*)(PWS + WS_POOLWT);
    for (int i = gtid; i < NL * 1024 * 64; i += gthreads) { const int l = i >> 16, c = (i >> 6) & 1023, j = i & 63; const size_t s = ((size_t)l * 64 + j) * 1024 + c; wupT[i] = f2bf(PIN(I_WUP)[s]); aupT[i] = f2bf(PIN(I_AUP)[s]); }
    for (int i = gtid; i < NL * 4 * 128 * 128; i += gthreads) { const int lg = i >> 14, d = (i >> 7) & 127, c = i & 127; poolwT[i] = f2bf(PIN(I_POOLW)[((size_t)lg * 128 + c) * 128 + d]); }
}

DEVINL void item_prep(const Params& p, unsigned char* lds, int tt, int l, int z, int wv) {
    LAUNDER_PTRS;
    const int tid = mk_tid(wv, z), lane = tid & 63, w = tid >> 6, fr = lane & 15, fq = lane >> 4;
    const int m0 = tt * 16;
    const bf16_t* proj = (const bf16_t*)(PWS + WS_PROJ);
    const float* mu = PIN(I_MU) + l * SHW;
    constexpr int RS = 3208;
    bf16_t* L = (bf16_t*)lds; bf16_t* Aw = L + 18 * RS; bf16_t* Aa = Aw + 16 * 72;
    {
        const bf16_t* srcA; const bf16_t* srcB;
        if (m0 < MP) { srcA = (m0 & 2047) ? proj + (size_t)(m0 - 1) * DINP : (const bf16_t*)(PWS + WS_ZROW); srcB = proj + (size_t)(m0 + 7) * DINP; }
        else { const int b0 = (m0 - MP) >> 3; srcA = (const bf16_t*)(PWS + WS_PREV) + ((size_t)l * 128 + b0) * SHW; srcB = srcA + SHW; }
        u32x4 st[15];
#pragma unroll
        for (int k = 0; k < 15; ++k) {
            const int idx = tid + k * 512, r = idx / 400, pc = idx % 400;
            const bf16_t* src = (r == 0) ? srcA : (r == 9) ? srcB : proj + (size_t)(m0 + (r < 9 ? r - 1 : r - 2)) * DINP;
            st[k] = (u32x4){0u, 0u, 0u, 0u};
            if (idx < 18 * 400) st[k] = *(const u32x4*)(src + pc * 8);
        }
#pragma unroll
        for (int k = 0; k < 15; ++k) { const int idx = tid + k * 512, r = idx / 400, pc = idx % 400; if (idx < 18 * 400) *(u32x4*)(L + r * RS + pc * 8) = st[k]; }
    }
    __syncthreads();
    for (int e = tid; e < 2048; e += 512) {
        const int tok = e >> 7, j = e & 127, c = 3072 + j, lr = tok + 1 + (tok >> 3);
        const float cur = bf2f(L[lr * RS + c]), prv = bf2f(L[(lr - 1) * RS + c]);
        const float x = cur + (prv - cur) * mu[c];
        if (j < 64) Aw[tok * 72 + j] = f2bf(1.f - 2.f * __builtin_amdgcn_rcpf(1.f + __expf(2.f * x))); else Aa[tok * 72 + (j - 64)] = f2bf(x);
    }
    __syncthreads();
    bf16x8 tw[2], ta[2];
#pragma unroll
    for (int ks = 0; ks < 2; ++ks) { tw[ks] = *(const bf16x8*)(Aw + fr * 72 + ks * 32 + fq * 8); ta[ks] = *(const bf16x8*)(Aa + fr * 72 + ks * 32 + fq * 8); }
    const int m = m0 + fr;
    const bf16_t* prow = L + (fr + 1 + (fr >> 3)) * RS;
    const bf16_t* pprev = prow - RS;
    const bf16_t* wupT = (const bf16_t*)(PWS + WS_WUPT) + (size_t)l * 1024 * 64; const bf16_t* aupT = (const bf16_t*)(PWS + WS_AUPT) + (size_t)l * 1024 * 64;
    const float* w0 = PIN(I_W0) + l * 1024; const float* a0 = PIN(I_A0) + l * 1024; const float* k_k = PIN(I_KK) + l * 1024; const float* k_a = PIN(I_KA) + l * 1024; const float* r_k = PIN(I_RK) + l * 1024;
    bf16_t* sc = (bf16_t*)(PWS + WS_SCAN); float* rkb = (float*)(PWS + WS_RKB);
#pragma unroll 2
    for (int hh = 0; hh < 2 * REP_PR2; ++hh) {
        const int h = w * 2 + (hh & 1);
        f32x4 aw[4], aa[4];
#pragma unroll
        for (int nt = 0; nt < 4; ++nt) {
            const int crow = h * 64 + (fr >> 2) * 16 + nt * 4 + (fr & 3);
            aw[nt] = (f32x4){0.f, 0.f, 0.f, 0.f}; aa[nt] = (f32x4){0.f, 0.f, 0.f, 0.f};
#pragma unroll
            for (int ks = 0; ks < 2; ++ks) {
                const bf16x8 fw = *(const bf16x8*)(wupT + (size_t)crow * 64 + ks * 32 + fq * 8), fa = *(const bf16x8*)(aupT + (size_t)crow * 64 + ks * 32 + fq * 8);
                aw[nt] = mfma16(fw, tw[ks], aw[nt]); aa[nt] = mfma16(fa, ta[ks], aa[nt]);
            }
        }
        u32x4 Rc[2], Kc[2], Vc[2], Rp[2], Kp[2], Vp[2];
        { const int cb = h * 64 + fq * 16;
#pragma unroll
          for (int q = 0; q < 2; ++q) { Rc[q] = *(const u32x4*)(prow + cb + q * 8); Kc[q] = *(const u32x4*)(prow + 1024 + cb + q * 8); Vc[q] = *(const u32x4*)(prow + 2048 + cb + q * 8);
              Rp[q] = *(const u32x4*)(pprev + cb + q * 8); Kp[q] = *(const u32x4*)(pprev + 1024 + cb + q * 8); Vp[q] = *(const u32x4*)(pprev + 2048 + cb + q * 8); } }
#define UNPK(P, nt) ((f32x4){__uint_as_float(P[(nt) >> 1][((nt) & 1) * 2] << 16), __uint_as_float(P[(nt) >> 1][((nt) & 1) * 2] & 0xFFFF0000u), __uint_as_float(P[(nt) >> 1][((nt) & 1) * 2 + 1] << 16), __uint_as_float(P[(nt) >> 1][((nt) & 1) * 2 + 1] & 0xFFFF0000u)})
        bf16_t* rec = sc + ((size_t)m * 16 + h) * REC + fq * 16;
        f32x4 kkq[4], aq[4]; float ss = 0.f, rk = 0.f;
        u32x2 pd[4], pkp[4], pr_[4], pv_[4];
#pragma unroll
        for (int nt = 0; nt < 4; ++nt) {
            const int c = h * 64 + fq * 16 + nt * 4;
            const f32x4 cr = UNPK(Rc, nt), ck = UNPK(Kc, nt), cv = UNPK(Vc, nt), pr = UNPK(Rp, nt), pk = UNPK(Kp, nt), pv = UNPK(Vp, nt);
            const f32x4 muk = *(const f32x4*)(mu + 1024 + c), kkw = *(const f32x4*)(k_k + c);
            const f32x4 r = cr + (pr - cr) * *(const f32x4*)(mu + c), k = ck + (pk - ck) * muk, v = cv + (pv - cv) * *(const f32x4*)(mu + 2048 + c);
            const f32x4 wp = aw[nt] + *(const f32x4*)(w0 + c), ap = aa[nt] + *(const f32x4*)(a0 + c);
            f32x4 dv, av;
#pragma unroll
            for (int e = 0; e < 4; ++e) {
                dv[e] = -0.60653066f * __builtin_amdgcn_rcpf(1.f + __expf(-wp[e]));
                av[e] = __builtin_amdgcn_rcpf(1.f + __expf(-ap[e]));
            }
            const f32x4 kk = k * kkw;
            ss += kk[0] * kk[0] + kk[1] * kk[1] + kk[2] * kk[2] + kk[3] * kk[3];
            const f32x4 kp = k * (1.f + (av - 1.f) * *(const f32x4*)(k_a + c));
            const f32x4 rkv = r * kp * *(const f32x4*)(r_k + c);
            rk += rkv[0] + rkv[1] + rkv[2] + rkv[3];
            pd[nt] = (u32x2){cvt_pk(dv[0], dv[1]), cvt_pk(dv[2], dv[3])}; pkp[nt] = (u32x2){cvt_pk(kp[0], kp[1]), cvt_pk(kp[2], kp[3])};
            pr_[nt] = (u32x2){cvt_pk(r[0], r[1]), cvt_pk(r[2], r[3])}; pv_[nt] = (u32x2){cvt_pk(v[0], v[1]), cvt_pk(v[2], v[3])};
            kkq[nt] = kk; aq[nt] = av;
        }
        ss = xq_sum(ss); rk = xq_sum(rk);
        const float inv = rsqrtf(fmaxf(ss, 1e-12f));
        u32x2 pn[4], pb_[4];
#pragma unroll
        for (int nt = 0; nt < 4; ++nt) {
            const f32x4 kn = kkq[nt] * inv, bb = kn * aq[nt];
            pn[nt] = (u32x2){cvt_pk(-kn[0], -kn[1]), cvt_pk(-kn[2], -kn[3])}; pb_[nt] = (u32x2){cvt_pk(bb[0], bb[1]), cvt_pk(bb[2], bb[3])};
        }
#define ST16(vec, P) do { *(u32x4*)(rec + (vec) * 64) = (u32x4){P[0].x, P[0].y, P[1].x, P[1].y}; *(u32x4*)(rec + (vec) * 64 + 8) = (u32x4){P[2].x, P[2].y, P[3].x, P[3].y}; } while (0)
        ST16(0, pd); ST16(1, pn); ST16(2, pb_); ST16(3, pkp); ST16(4, pr_); ST16(5, pv_);
#undef ST16
        if (fq == 0) rkb[((size_t)m * 16 + h) * 4] = rk;
    }
#undef UNPK
    __syncthreads();
}

DEVINL void item_pool(const Params& p, unsigned char* lds, int pt, int g, int l, int z, int wv) {
    LAUNDER_PTRS;
    const int tid = mk_tid(wv, z), lane = tid & 63, w = tid >> 6, fr = lane & 15, fq = lane >> 4;
    const int m0 = pt * 64, win = 2 << g; const bool smp = pt >= 128;
    const bf16_t* proj = (const bf16_t*)(PWS + WS_PROJ); bf16_t* cat = (bf16_t*)(PWS + WS_CAT);
    const float* stp = PIN(I_SPOOL) + (size_t)l * 128 * 15 * 512;
    bf16_t* Ap = (bf16_t*)lds;
    float* U = (float*)(lds + 64 * 136 * 2);
    if (!smp) {
        const int t0 = m0 & 2047;
        u32x2 raw[5];
#pragma unroll
        for (int k = 0; k < 5; ++k) { const int idx = tid + k * 512, r = idx >> 5, q = idx & 31; raw[k] = (u32x2){0u, 0u};
            if (idx < 79 * 32 && t0 - 15 + r >= 0) raw[k] = *(const u32x2*)(proj + (size_t)(m0 - 15 + r) * DINP + C_UB + g * 128 + q * 4); }
#pragma unroll
        for (int k = 0; k < 5; ++k) { const int idx = tid + k * 512, r = idx >> 5, q = idx & 31;
            if (idx < 79 * 32) *(f32x4*)(U + r * 132 + q * 4) = (f32x4){__uint_as_float(raw[k].x << 16), __uint_as_float(raw[k].x & 0xFFFF0000u), __uint_as_float(raw[k].y << 16), __uint_as_float(raw[k].y & 0xFFFF0000u)}; }
    } else {
        const int b0 = (m0 - MP) >> 3;
#pragma unroll
        for (int k0 = 0; k0 < 12; k0 += 6) {
            f32x4 vv[6];
#pragma unroll
            for (int k = 0; k < 6; ++k) { const int idx = tid + (k0 + k) * 512, r = idx >> 5, q = idx & 31, bl = r / 23, rr = r % 23; vv[k] = (f32x4){0.f, 0.f, 0.f, 0.f};
                if (idx < 184 * 32) { if (rr < 15) vv[k] = *(const f32x4*)(stp + ((size_t)(b0 + bl) * 15 + rr) * 512 + g * 128 + q * 4); else vv[k] = ld4bf(proj + (size_t)(m0 + bl * 8 + rr - 15) * DINP + C_UB + g * 128 + q * 4); } }
#pragma unroll
            for (int k = 0; k < 6; ++k) { const int idx = tid + (k0 + k) * 512, r = idx >> 5, q = idx & 31; if (idx < 184 * 32) *(f32x4*)(U + r * 132 + q * 4) = vv[k]; }
        }
    }
    __syncthreads();
    {
        const int col = tid & 127, tb = (tid >> 7) * 16;
#pragma unroll
        for (int hf = 0; hf < 2; ++hf) {
            const int tok0 = tb + hf * 8;
            const int rr0 = smp ? ((tok0 >> 3) * 23 + 15) : (15 + tok0);
            const float* up = U + rr0 * 132 + col;
            float sum = 0.f;
#pragma unroll
            for (int d = 0; d < 16; ++d) { const float x = up[-(d < win ? d : 0) * 132]; sum += (d < win) ? x : 0.f; }
#pragma unroll
            for (int i = 0; i < 8; ++i) {
                const int tok = tok0 + i;
                const float u0 = up[i * 132];
                if (i > 0) sum += u0 - up[(i - win) * 132];
                const float cnt = smp ? (float)win : (float)min(((m0 + tok) & 2047) + 1, win);
                Ap[tok * 136 + col] = f2bf(sum * __builtin_amdgcn_rcpf(cnt) - u0);
            }
        }
    }
    __syncthreads();
    const bf16_t* pw = (const bf16_t*)(PWS + WS_POOLWT) + (size_t)(l * 4 + g) * 128 * 128;
    bf16x8 fa[4];
#pragma unroll
    for (int ks = 0; ks < 4; ++ks) fa[ks] = *(const bf16x8*)(pw + (size_t)(w * 16 + fr) * 128 + ks * 32 + fq * 8);
    const int d0 = g * 128 + w * 16 + fq * 4;
    const f32x4 scl = *(const f32x4*)(PIN(I_POOLS) + l * 512 + d0);
#pragma unroll
    for (int mt = 0; mt < 4; ++mt) {
        f32x4 acc = {0.f, 0.f, 0.f, 0.f};
#pragma unroll
        for (int ks = 0; ks < 4; ++ks) acc = mfma16(fa[ks], *(const bf16x8*)(Ap + (mt * 16 + fr) * 136 + ks * 32 + fq * 8), acc);
        const int m = m0 + mt * 16 + fr;
        const f32x4 gb = ld4bf(proj + (size_t)m * DINP + C_GB + d0);
        f32x4 o;
#pragma unroll
        for (int e = 0; e < 4; ++e) o[e] = acc[e] * scl[e] * siluf(gb[e]);
        st4bf(cat + (size_t)m * DM + 1024 + d0, o);
    }
    __syncthreads();
}

DEVINL void item_chunk(const Params& p, unsigned char* lds, int ck, int g, int l, int z, int wv) {
    LAUNDER_PTRS;
    const int tid = mk_tid(wv, z), lane = tid & 63, w = tid >> 6, fr = lane & 15, fq = lane >> 4;
    const int m0 = ck * 128; const bool smp = ck >= 64;
    const bf16_t* proj = (const bf16_t*)(PWS + WS_PROJ); bf16_t* cat = (bf16_t*)(PWS + WS_CAT);
    bf16_t* vnT = (bf16_t*)lds;
    bf16_t* Aws = vnT + 128 * 136;
    float* stats = (float*)(Aws + 128 * 136);
    const int tok = tid >> 2, part = tid & 3, m = m0 + tok;
    {
        const bf16_t* vp = proj + (size_t)m * DINP + C_VC + part * 128;
        float s = 0.f, q = 0.f;
#pragma unroll
        for (int i = 0; i < 32; ++i) { const f32x4 v = ld4bf(vp + i * 4); s += v[0] + v[1] + v[2] + v[3]; q += v[0] * v[0] + v[1] * v[1] + v[2] * v[2] + v[3] * v[3]; }
        s += __shfl_xor(s, 1); s += __shfl_xor(s, 2); q += __shfl_xor(q, 1); q += __shfl_xor(q, 2);
        const float mean = s * (1.f / 512.f), var = fmaxf(q * (1.f / 512.f) - mean * mean, 0.f);
        if (part == 0) { stats[tok * 2] = mean; stats[tok * 2 + 1] = rsqrtf(var + 1e-5f); }
    }
    __syncthreads();
    {
        const float mean = stats[tok * 2], rstd = stats[tok * 2 + 1];
        const float* lng = PIN(I_GLNG) + l * 512 + g * 128 + part * 32;
        const bf16_t* vp = proj + (size_t)m * DINP + C_VC + g * 128 + part * 32;
#pragma unroll
        for (int i = 0; i < 8; ++i) {
            const f32x4 v = ld4bf(vp + i * 4); const f32x4 gg = *(const f32x4*)(lng + i * 4);
            f32x4 vn;
#pragma unroll
            for (int e = 0; e < 4; ++e) { vn[e] = (v[e] - mean) * rstd * gg[e]; vnT[(part * 32 + i * 4 + e) * 136 + tok] = f2bf(vn[e]); }
            if (smp) *(f32x4*)(POUT + O_SV + ((size_t)l * 1024 + (m - MP)) * 512 + g * 128 + part * 32 + i * 4) = vn;
        }
        const float* wsg = PIN(I_GWS) + (size_t)(l * 4 + g) * 128 * 128;
        const int t = tok;
#pragma unroll
        for (int i = 0; i < 8; ++i) {
            const int s0 = part * 32 + i * 4;
            f32x4 a;
            if (!smp) { a = *(const f32x4*)(wsg + (size_t)t * 128 + s0);
#pragma unroll
                for (int e = 0; e < 4; ++e) a[e] = (s0 + e <= t) ? a[e] : 0.f; }
            else {
#pragma unroll
                for (int e = 0; e < 4; ++e) { const int s = s0 + e; a[e] = ((s >> 3) == (t >> 3) && (s & 7) <= (t & 7)) ? wsg[(t & 7) * 128 + (s & 7)] : 0.f; } }
            st4bf(Aws + t * 136 + s0, a);
        }
    }
    __syncthreads();
    bf16x8 fa[4];
#pragma unroll
    for (int ks = 0; ks < 4; ++ks) fa[ks] = *(const bf16x8*)(vnT + (w * 16 + fr) * 136 + ks * 32 + fq * 8);
    const int c0 = g * 128 + w * 16 + fq * 4;
    const float* gbias = PIN(I_GB) + (l * 4 + g) * 128;
    u32x2 ucr[8], gcr[8];
#pragma unroll
    for (int tt = 0; tt < 8; ++tt) { const size_t ro = (size_t)(m0 + tt * 16 + fr) * DINP + c0; ucr[tt] = *(const u32x2*)(proj + ro + C_UC); gcr[tt] = *(const u32x2*)(proj + ro + C_GC); }
#pragma unroll
    for (int tt = 0; tt < 8; ++tt) {
        f32x4 acc = {0.f, 0.f, 0.f, 0.f};
#pragma unroll
        for (int ks = 0; ks < 4; ++ks) {
            const bool need = smp ? (ks == (tt >> 1)) : (ks <= (tt >> 1));
            if (need) acc = mfma16(fa[ks], *(const bf16x8*)(Aws + (tt * 16 + fr) * 136 + ks * 32 + fq * 8), acc);
        }
        const int t = tt * 16 + fr, mm = m0 + t;
        const float bias = gbias[smp ? (t & 7) : t];
        f32x4 uc, gc;
        uc[0] = __uint_as_float(ucr[tt].x << 16); uc[1] = __uint_as_float(ucr[tt].x & 0xFFFF0000u); uc[2] = __uint_as_float(ucr[tt].y << 16); uc[3] = __uint_as_float(ucr[tt].y & 0xFFFF0000u);
        gc[0] = __uint_as_float(gcr[tt].x << 16); gc[1] = __uint_as_float(gcr[tt].x & 0xFFFF0000u); gc[2] = __uint_as_float(gcr[tt].y << 16); gc[3] = __uint_as_float(gcr[tt].y & 0xFFFF0000u);
        f32x4 o;
#pragma unroll
        for (int e = 0; e < 4; ++e) o[e] = uc[e] * (acc[e] + bias) * siluf(gc[e]);
        st4bf(cat + (size_t)mm * DM + 1536 + c0, o);
    }
    __syncthreads();
}

DEVINL void phase2a(const Params& p, unsigned char* lds, int l, int z, int wv) {
    LAUNDER_PTRS;
    const int G = gridDim.x, bid = (int)(blockIdx.x + z), tid = mk_tid(wv, z);
    for (int it = bid; it < 288 + 576 + 576; it += G) {
        if (it < 288) { for (int rep = 0; rep < REP_CH; ++rep) item_chunk(p, lds, it >> 2, it & 3, l, z, wv); }
        else if (it < 864) { const int j = it - 288; for (int rep = 0; rep < REP_PL; ++rep) item_pool(p, lds, j >> 2, j & 3, l, z, wv); }
        else { for (int rep = 0; rep < REP_PR; ++rep) item_prep(p, lds, it - 864, l, z, wv); }
    }
    const bf16_t* proj = (const bf16_t*)(PWS + WS_PROJ);
    const int gtid = bid * 512 + tid, gthreads = G * 512;
    for (int i = gtid; i < 132 * (SHW / 4); i += gthreads) {
        const int b = i / (SHW / 4), c = (i % (SHW / 4)) * 4;
        if (b < 4) *(f32x4*)(POUT + O_PSHIFT + ((size_t)l * 4 + b) * SHW + c) = ld4bf(proj + (size_t)(b * 2048 + 2047) * DINP + c);
        else *(f32x4*)(POUT + O_SSHIFT + ((size_t)l * 128 + (b - 4)) * SHW + c) = ld4bf(proj + (size_t)(MP + (b - 4) * 8 + 7) * DINP + c);
    }
    for (int i = gtid; i < 132 * 15 * 128; i += gthreads) {
        const int b = i / (15 * 128), r = (i / 128) % 15, c = (i % 128) * 4;
        if (b < 4) *(f32x4*)(POUT + O_PPOOL + (((size_t)l * 4 + b) * 15 + r) * 512 + c) = ld4bf(proj + (size_t)(b * 2048 + 2033 + r) * DINP + C_UB + c);
        else { const int bb = b - 4;
            *(f32x4*)(POUT + O_SPOOL + (((size_t)l * 128 + bb) * 15 + r) * 512 + c) = (r < 7) ? *(const f32x4*)(PIN(I_SPOOL) + (((size_t)l * 128 + bb) * 15 + 8 + r) * 512 + c) : ld4bf(proj + (size_t)(MP + bb * 8 + (r - 7)) * DINP + C_UB + c); }
    }
}
typedef float f32x2 __attribute__((ext_vector_type(2)));
#define LDS_BARRIER() do { asm volatile("s_waitcnt lgkmcnt(0)" ::: "memory"); __builtin_amdgcn_s_barrier(); asm volatile("" ::: "memory"); } while (0)
struct ScanOps { f32x4 w, b, k, r; float v; };
DEVINL float dot4(f32x2 s01, f32x2 s23, f32x4 x) { f32x2 t = s01 * (f32x2){x[0], x[1]}; t = s23 * (f32x2){x[2], x[3]} + t; return t[0] + t[1]; }
DEVINL void dual_allreduce16(float& a, float& b) {
    a = dpp_add<0x128>(a); b = dpp_add<0x128>(b); a = dpp_add<0x124>(a); b = dpp_add<0x124>(b);
    a = dpp_add<0x122>(a); b = dpp_add<0x122>(b); a = dpp_add<0x121>(a); b = dpp_add<0x121>(b);
}
#define SCAN_LOAD(o, sp, irow) do { (o).w = *(const f32x4*)((sp) + kq * 4); (o).b = *(const f32x4*)((sp) + 128 + kq * 4); (o).k = *(const f32x4*)((sp) + 192 + kq * 4); (o).r = *(const f32x4*)((sp) + 256 + kq * 4); (o).v = (sp)[320 + (irow)]; } while (0)
#define SCAN_UPD(S01, S23, o, sa) do { \
        S01 = S01 * (f32x2){(o).w[0], (o).w[1]} + (f32x2){(o).b[0], (o).b[1]} * (sa) + (f32x2){(o).k[0], (o).k[1]} * (o).v; \
        S23 = S23 * (f32x2){(o).w[2], (o).w[3]} + (f32x2){(o).b[2], (o).b[3]} * (sa) + (f32x2){(o).k[2], (o).k[3]} * (o).v; } while (0)

DEVINL void piece_to_lds(float* dst, u32x4 w, bool is_decay) {
    f32x4 lo, hi;
    lo[0] = __uint_as_float(w.x << 16); lo[1] = __uint_as_float(w.x & 0xFFFF0000u); lo[2] = __uint_as_float(w.y << 16); lo[3] = __uint_as_float(w.y & 0xFFFF0000u);
    hi[0] = __uint_as_float(w.z << 16); hi[1] = __uint_as_float(w.z & 0xFFFF0000u); hi[2] = __uint_as_float(w.w << 16); hi[3] = __uint_as_float(w.w & 0xFFFF0000u);
    if (is_decay) {
#pragma unroll
        for (int e = 0; e < 4; ++e) { lo[e] = __expf(lo[e]); hi[e] = __expf(hi[e]); }
    }
    *(f32x4*)dst = lo; *(f32x4*)(dst + 4) = hi;
}

constexpr int TC = 16, NCH = 2048 / TC;
constexpr int SLOT = TC * 384 + 64;
struct ScanOps2 { f32x4 w, g, b, k, r; float v; f32x2 bk; };
#define SCAN_LOAD2(o, cb, s, irow) do { const float* sp_ = (cb) + (s) * 384; (o).w = *(const f32x4*)(sp_ + kq * 4); (o).g = *(const f32x4*)(sp_ + 64 + kq * 4); (o).b = *(const f32x4*)(sp_ + 128 + kq * 4); \
        (o).k = *(const f32x4*)(sp_ + 192 + kq * 4); (o).r = *(const f32x4*)(sp_ + 256 + kq * 4); (o).v = sp_[320 + (irow)]; (o).bk = *(const f32x2*)((cb) + TC * 384 + (s) * 2); } while (0)
DEVINL void scan_prompt(const Params& p, unsigned char* lds, int it, int l, int z, int wv) {
    LAUNDER_PTRS;
    const int tid = mk_tid(wv, z), w = tid >> 6, lane = tid & 63;
    const int v = (it & 7) * 32 + (it >> 3), bh = v >> 2, q4 = v & 3, b = bh >> 4, h = bh & 15, hc = h * 64;
    float* buf = (float*)lds;
    float* ypb = buf + 2 * TC * 384;
    const bf16_t* sc = (const bf16_t*)(PWS + WS_SCAN); float* ybuf = (float*)(PWS + WS_Y);
    const size_t rowbase = (size_t)b * 2048;
    if (w >= 4) {
        const int lt = tid - 256;
        int goff[3], loff[3]; bool dec[3];
#pragma unroll
        for (int q = 0; q < 3; ++q) { const int pi = lt + 256 * q, t = pi / 48, r = pi % 48; goff[q] = t * 16 * REC + r * 8; loff[q] = t * 384 + (r >> 3) * 64 + (r & 7) * 8; dec[q] = (r >> 3) == 0; }
        const bf16_t* gb = sc + (rowbase * 16 + h) * REC;
        u32x4 pa[3], pb[3];
#define LD_ISSUE(set, c) do { _Pragma("unroll") for (int q = 0; q < 3; ++q) set[q] = *(const u32x4*)(gb + (size_t)(c) * (TC * 16 * REC) + goff[q]); } while (0)
#define LD_WRITE(set, slot) do { _Pragma("unroll") for (int q = 0; q < 3; ++q) piece_to_lds(buf + (slot) * (TC * 384) + loff[q], set[q], dec[q]); } while (0)
#define Y_FLUSH(c) do { const float* yp_ = ypb + ((c) & 1) * (TC * 256) + lt * 16; const f32x4 a_ = *(const f32x4*)yp_, b_ = *(const f32x4*)(yp_ + 4), c_ = *(const f32x4*)(yp_ + 8), d_ = *(const f32x4*)(yp_ + 12); \
        const f32x4 s_ = (a_ + b_) + (c_ + d_); ybuf[(rowbase + (size_t)(c) * TC + (lt >> 4)) * 1024 + hc + q4 * 16 + (lt & 15)] = (s_[0] + s_[1]) + (s_[2] + s_[3]); } while (0)
        LD_ISSUE(pa, 0); LD_WRITE(pa, 0); LD_ISSUE(pb, 1); LD_ISSUE(pa, 2);
        LDS_BARRIER();
        for (int c = 0; c < NCH; c += 2) {
            if (c > 0) Y_FLUSH(c - 1);
            LD_WRITE(pb, 1); if (c + 3 < NCH) LD_ISSUE(pb, c + 3);
            LDS_BARRIER();
            Y_FLUSH(c);
            if (c + 2 < NCH) LD_WRITE(pa, 0);
            if (c + 4 < NCH) LD_ISSUE(pa, c + 4);
            LDS_BARRIER();
        }
        Y_FLUSH(NCH - 1);
#undef LD_ISSUE
#undef LD_WRITE
#undef Y_FLUSH
    } else {
        const int il = lane >> 4, kq = lane & 15, i = q4 * 16 + w * 4 + il;
        f32x2 S01 = {0.f, 0.f}, S23 = {0.f, 0.f};
        LDS_BARRIER();
        for (int c = 0; c < NCH; ++c) {
            const float* cb = buf + (c & 1) * (TC * 384);
            float* yp = ypb + (c & 1) * (TC * 256) + w * 64 + lane;
            ScanOps cur; SCAN_LOAD(cur, cb, i); f32x4 nk = *(const f32x4*)(cb + 64 + kq * 4);
#pragma unroll
            for (int s = 0; s < TC; ++s) {
                ScanOps nxt; f32x4 nkn;
                if (s + 1 < TC) { SCAN_LOAD(nxt, cb + (s + 1) * 384, i); nkn = *(const f32x4*)(cb + (s + 1) * 384 + 64 + kq * 4); }
                const float sa = allreduce16(dot4(S01, S23, nk));
                SCAN_UPD(S01, S23, cur, sa);
                yp[s * 256] = dot4(S01, S23, cur.r);
                if (s + 1 < TC) { cur = nxt; nk = nkn; }
            }
            LDS_BARRIER();
        }
        *(f32x4*)(POUT + O_PWKV + ((((size_t)l * 4 + b) * 16 + h) * 64 + i) * 64 + kq * 4) = (f32x4){S01[0], S01[1], S23[0], S23[1]};
    }
}

DEVINL void scan_sample_all(const Params& p, unsigned char* lds, int l, int z, int wv) {
    LAUNDER_PTRS;
    const int tid = mk_tid(wv, z), w = tid >> 6, lane = tid & 63, il = lane >> 4, kq = lane & 15;
    const int G = gridDim.x;
    float* buf = (float*)lds;
    const bf16_t* sc = (const bf16_t*)(PWS + WS_SCAN); float* ybuf = (float*)(PWS + WS_Y);
    const int ia = w * 4 + il, ib = ia + 32;
    const bool ldr = tid < 384;
    const int t_0 = tid / 48, r_0 = tid % 48;
    int it = (int)(blockIdx.x + z);
    u32x4 in0 = {0u, 0u, 0u, 0u}; f32x4 Sa, Sb;
#define SMP_PRELOAD(itx) do { const int b_ = (itx) >> 4, h_ = (itx) & 15; \
        if (ldr) in0 = *(const u32x4*)(sc + (((size_t)MP + b_ * 8 + t_0) * 16 + h_) * REC + r_0 * 8); \
        const size_t sb_ = ((size_t)l * 2048 + (itx)) * 4096; Sa = *(const f32x4*)(PIN(I_SWKV) + sb_ + ia * 64 + kq * 4); Sb = *(const f32x4*)(PIN(I_SWKV) + sb_ + ib * 64 + kq * 4); } while (0)
    if (it < 2048) SMP_PRELOAD(it);
    while (it < 2048) {
        if (ldr) piece_to_lds(buf + t_0 * 384 + (r_0 >> 3) * 64 + (r_0 & 7) * 8, in0, (r_0 >> 3) == 0);
        f32x2 A01 = {Sa[0], Sa[1]}, A23 = {Sa[2], Sa[3]}, B01 = {Sb[0], Sb[1]}, B23 = {Sb[2], Sb[3]};
        LDS_BARRIER();
        const int nxt = it + G;
        if (nxt < 2048) SMP_PRELOAD(nxt);
        const int b = it >> 4, hc = (it & 15) * 64; const size_t row0 = (size_t)MP + b * 8;
        float ka = 0.f, kb = 0.f;
#pragma unroll
        for (int s = 0; s < 8; ++s) {
            const float* sp = buf + s * 384;
            const f32x4 nk = *(const f32x4*)(sp + 64 + kq * 4);
            ScanOps oa; SCAN_LOAD(oa, sp, ia); const float vb = sp[320 + ib];
            float sa = dot4(A01, A23, nk), sb = dot4(B01, B23, nk); dual_allreduce16(sa, sb);
            SCAN_UPD(A01, A23, oa, sa); oa.v = vb; SCAN_UPD(B01, B23, oa, sb);
            float ya = dot4(A01, A23, oa.r), yb = dot4(B01, B23, oa.r); dual_allreduce16(ya, yb);
            ka = (kq == s) ? ya : ka; kb = (kq == s) ? yb : kb;
        }
        if (kq < 8) { ybuf[(row0 + kq) * 1024 + hc + ia] = ka; ybuf[(row0 + kq) * 1024 + hc + ib] = kb; }
        const size_t sbase = ((size_t)l * 2048 + it) * 4096;
        *(f32x4*)(POUT + O_SWKV + sbase + ia * 64 + kq * 4) = (f32x4){A01[0], A01[1], A23[0], A23[1]};
        *(f32x4*)(POUT + O_SWKV + sbase + ib * 64 + kq * 4) = (f32x4){B01[0], B01[1], B23[0], B23[1]};
        LDS_BARRIER();
        it = nxt;
    }
#undef SMP_PRELOAD
}

DEVINL void phase2b(const Params& p, unsigned char* lds, int l, int z, int wv) {
    const int G = gridDim.x, bid = (int)(blockIdx.x + z);
    for (int rep = 0; rep < REP_PS; ++rep) for (int it = bid; it < 256; it += G) scan_prompt(p, lds, it, l, z, wv);
    for (int rep = 0; rep < REP_SP; ++rep) scan_sample_all(p, lds, l, z, wv);
}

DEVINL void phase2c(const Params& p, int l, int z, int wv) {
    LAUNDER_PTRS;
    const int gtid = (int)(blockIdx.x + z) * 512 + mk_tid(wv, z), gthreads = gridDim.x * 512;
    const float* ybuf = (const float*)(PWS + WS_Y); const bf16_t* scr = (const bf16_t*)(PWS + WS_SCAN); const float* rkb = (const float*)(PWS + WS_RKB);
    const bf16_t* proj = (const bf16_t*)(PWS + WS_PROJ); bf16_t* cat = (bf16_t*)(PWS + WS_CAT);
    const float* lg = PIN(I_LNXG) + l * 1024; const float* lb = PIN(I_LNXB) + l * 1024;
    for (int i0 = gtid; i0 < MTOT * 256; i0 += 2 * gthreads) {
        f32x4 y[2], vv[2], ga[2]; float bon[2]; int mm[2], cc[2]; bool ok[2];
#pragma unroll
        for (int u = 0; u < 2; ++u) {
            const int i = i0 + u * gthreads; ok[u] = i < MTOT * 256; const int ii = ok[u] ? i : i0;
            const int m = ii >> 8, c = (ii & 255) * 4, h = c >> 6; mm[u] = m; cc[u] = c;
            y[u] = *(const f32x4*)(ybuf + (size_t)m * 1024 + c);
            vv[u] = ld4bf(scr + ((size_t)m * 16 + h) * REC + 5 * 64 + (c & 63)); bon[u] = rkb[((size_t)m * 16 + h) * 4];
            ga[u] = ld4bf(proj + (size_t)m * DINP + C_GA + c);
        }
#pragma unroll
        for (int u = 0; u < 2; ++u) {
            const int m = mm[u], c = cc[u];
            const float mean = allreduce16(y[u][0] + y[u][1] + y[u][2] + y[u][3]) * (1.f / 64.f);
            const f32x4 d = y[u] - mean;
            const float var = allreduce16(d[0] * d[0] + d[1] * d[1] + d[2] * d[2] + d[3] * d[3]) * (1.f / 64.f);
            const float rs = rsqrtf(var + 64e-5f);
            const f32x4 g4 = *(const f32x4*)(lg + c), b4 = *(const f32x4*)(lb + c);
            f32x4 o;
#pragma unroll
            for (int e = 0; e < 4; ++e) o[e] = (d[e] * rs * g4[e] + b4[e] + bon[u] * vv[u][e]) * siluf(ga[u][e]);
            if (ok[u]) st4bf(cat + (size_t)m * DM + c, o);
        }
    }
}

DEVINL void phase_final(const Params& p, int z, int wv) {
    LAUNDER_PTRS;
    const int gtid = (int)(blockIdx.x + z) * 512 + mk_tid(wv, z), gthreads = gridDim.x * 512;
    const float* xf = (const float*)(PWS + WS_XF); const float* ssq = (const float*)(PWS + WS_SSQ) + 4 * MTOT; const float* fg = PIN(I_FNORMG);
    for (int i0 = gtid; i0 < MTOT * 512; i0 += 4 * gthreads) {
        f32x4 xv[4]; float sq[4];
#pragma unroll
        for (int u = 0; u < 4; ++u) { const int i = i0 + u * gthreads; const int ii = i < MTOT * 512 ? i : i0; xv[u] = *(const f32x4*)(xf + (size_t)(ii >> 9) * DM + (ii & 511) * 4); sq[u] = ssq[ii >> 9]; }
#pragma unroll
        for (int u = 0; u < 4; ++u) { const int i = i0 + u * gthreads; if (i < MTOT * 512) { const int m = i >> 9, c = (i & 511) * 4;
            *(f32x4*)(POUT + (size_t)m * DM + c) = xv[u] * rsqrtf(sq[u] * (1.f / 2048.f) + 1e-6f) * *(const f32x4*)(fg + c); } }
    }
}

#ifndef REP_P0
#define REP_P0 1
#endif
#ifndef REP_G1
#define REP_G1 1
#endif
#ifndef REP_2A
#define REP_2A 1
#endif
#ifndef REP_2B
#define REP_2B 1
#endif
#ifndef REP_2C
#define REP_2C 1
#endif
#ifndef REP_SYNC
#define REP_SYNC 0
#endif
#define FRESH_Z(z) int z; asm volatile("s_mov_b32 %0, 0" : "=s"(z))
__global__ void __launch_bounds__(512, 2) hybrid_fwd(Params p) {
    extern __shared__ __attribute__((aligned(16))) unsigned char lds[];
    cg::grid_group grid = cg::this_grid();
    const int wv = __builtin_amdgcn_readfirstlane((int)threadIdx.x >> 6);
    volatile unsigned* bst = (volatile unsigned*)(lds + 131072);
    {
        FRESH_Z(z); LAUNDER_PTRS; const int tid = mk_tid(wv, z);
        if ((int)(blockIdx.x + z) == 0) for (int i = tid; i < XCD_BAR_WORDS; i += 512) ((unsigned*)(PWS + WS_BAR))[i] = 0u;
        if (tid < 2) bst[tid] = 0u;
    }
    for (int rep = 0; rep < REP_P0; ++rep) { FRESH_Z(z); phase0(p, lds, z, wv); }
    grid.sync();
#define GRID_BAR() do { FRESH_Z(zb); GLOBAL_AS unsigned char* wsb_ = p.ws; asm volatile("" : "+s"(wsb_)); xcd_barrier((unsigned*)(wsb_ + WS_BAR), bst, mk_tid(wv, zb)); } while (0)
    for (int l = 0; l < NL; ++l) {
        for (int rep = 0; rep < REP_G1; ++rep) {
            FRESH_Z(z); LAUNDER_PTRS;
            pg8::Gemm g; g.A = (const bf16_t*)(PWS + WS_XB); g.Bt = (const bf16_t*)(PWS + WS_WINT) + (size_t)l * DINP * DM; g.M = MTOT; g.N = DINP; g.K = DM;
            pg8::StaticOrder S; S.init(MTOT, DINP, (int)gridDim.x, (int)(blockIdx.x + z));
            EpiProj E; E.O = (bf16_t*)(PWS + WS_PROJ); E.ssq = (const float*)(PWS + WS_SSQ) + l * MTOT;
            pg8::gemm_phase<EpiProj, pg8::StaticOrder, false>((PG8_LAS unsigned char*)lds, g, S, E, nullptr, mk_tid(wv, z));
        }
        GRID_BAR();
        for (int rep = 0; rep < REP_2A; ++rep) { FRESH_Z(z); phase2a(p, lds, l, z, wv); }
        GRID_BAR();
        for (int rep = 0; rep < REP_2B; ++rep) { FRESH_Z(z); phase2b(p, lds, l, z, wv); }
        GRID_BAR();
        for (int rep = 0; rep < REP_2C; ++rep) { FRESH_Z(z); phase2c(p, l, z, wv); }
        for (int rep = 0; rep < REP_SYNC; ++rep) GRID_BAR();
        GRID_BAR();
        {
            FRESH_Z(z); LAUNDER_PTRS;
            pg8::Gemm g; g.A = (const bf16_t*)(PWS + WS_CAT); g.Bt = (const bf16_t*)(PWS + WS_WOUTT) + (size_t)l * DM * DM; g.M = MTOT; g.N = DM; g.K = DM;
            pg8::StaticOrder S; S.init(MTOT, DM, (int)gridDim.x, (int)(blockIdx.x + z));
            EpiRes E; E.srcP = l == 0 ? PIN(I_XP) : (const float*)(PWS + WS_XF); E.srcS = l == 0 ? PIN(I_XS) : (const float*)(PWS + WS_XF) + (size_t)MP * DM;
            E.xf = (float*)(PWS + WS_XF); E.xb = l + 1 < NL ? (bf16_t*)(PWS + WS_XB) : nullptr; E.ssq_next = (float*)(PWS + WS_SSQ) + (l + 1) * MTOT;
            pg8::gemm_phase<EpiRes, pg8::StaticOrder, false>((PG8_LAS unsigned char*)lds, g, S, E, nullptr, mk_tid(wv, z));
        }
        if (l + 1 < NL) {
            FRESH_Z(z);
            const int G = (int)gridDim.x, bidz = (int)(blockIdx.x + z), nb2 = (G < 288 && 288 - G < G) ? 288 - G : 0;
            if (bidz >= nb2) convert_layer(p, lds, l + 1, bidz - nb2, G - nb2, z, wv);
        }
        GRID_BAR();
    }
    { FRESH_Z(z); phase_final(p, z, wv); }
}

extern "C" void kernel_launch(void* const* d_in, const int* in_sizes, int n_in, void* d_out, int out_size, void* d_ws, size_t ws_size, hipStream_t stream) {
    static int grid = 0;
    if (grid == 0) {
        if (n_in != 24 || (size_t)out_size != O_END || ws_size < WS_END) { fprintf(stderr, "kernel_launch: unexpected shapes (n_in %d out %d ws %zu, need ws >= %zu)\n", n_in, out_size, ws_size, (size_t)WS_END); grid = -1; return; }
        int dev = 0, cus = 0, per_cu = 0;
        (void)hipGetDevice(&dev); (void)hipDeviceGetAttribute(&cus, hipDeviceAttributeMultiprocessorCount, dev);
        if (hipFuncSetAttribute((const void*)hybrid_fwd, hipFuncAttributeMaxDynamicSharedMemorySize, LDS_BYTES) != hipSuccess) { fprintf(stderr, "kernel_launch: hipFuncSetAttribute failed\n"); grid = -1; return; }
        if (hipOccupancyMaxActiveBlocksPerMultiprocessor(&per_cu, (const void*)hybrid_fwd, 512, LDS_BYTES) != hipSuccess || per_cu < 1) { fprintf(stderr, "kernel_launch: occupancy query says %d blocks per CU\n", per_cu); per_cu = 1; }
        (void)hipGetLastError();
        grid = cus;
        if (grid > 256) grid = 256;
    }
    if (grid < 0) return;
    Params p{};
    for (int i = 0; i < 24; ++i) p.in[i] = (GLOBAL_AS const float*)d_in[i];
    p.out = (GLOBAL_AS float*)d_out; p.ws = (GLOBAL_AS unsigned char*)d_ws;
    void* args[] = {&p};
    hipError_t e = hipLaunchCooperativeKernel((const void*)hybrid_fwd, dim3(grid), dim3(512), args, LDS_BYTES, stream);
    if (e != hipSuccess) fprintf(stderr, "kernel_launch: cooperative launch failed: %s (grid %d)\n", hipGetErrorString(e), grid);
}
```
